# Optimizing an MI355X kernel written in HIP

```python
import math
import jax, jax.numpy as jnp
from jax import lax
import numpy as np

D_MODEL = 1024
BATCH = 8
SEQ = 4096
DEPTH = 2

D_PLE = 256
A_HEADS = 4
A_DK = 128
A_DV = 128
A_WIDTH = A_HEADS * A_DK
B_HEADS = 8
B_DH = 64
B_WIDTH = B_HEADS * B_DH
D_MIX = A_WIDTH + B_WIDTH
IN_WIDTHS = (A_WIDTH, A_WIDTH, A_HEADS * A_DV, A_HEADS * A_DV,
             B_WIDTH, B_WIDTH, B_WIDTH, B_WIDTH)
D_IN = sum(IN_WIDTHS)
CHUNK = 64
Q_BLOCK = 128
EPS = 1e-6

kernel_name = "hymba_hgrn2_stickbreaking_trunk"


def rmsnorm(x, g):
    xf = x.astype(jnp.float32)
    y = xf * lax.rsqrt(jnp.mean(xf * xf, axis=-1, keepdims=True) + EPS)
    return (y * g.astype(jnp.float32)).astype(x.dtype)


def head_rmsnorm(o, g):
    B_, S_, H, d = o.shape
    y = o * lax.rsqrt(jnp.mean(o * o, axis=-1, keepdims=True) + EPS)
    return y.reshape(B_, S_, H * d) * g.astype(jnp.float32)


def hgrn2_chunkwise(q, k, v, log_f):
    B_, S_, H, dk = q.shape
    dv = v.shape[-1]
    n = S_ // CHUNK

    def to_chunks(t):
        return t.reshape(B_, n, CHUNK, H, t.shape[-1]).transpose(1, 0, 3, 2, 4)

    causal = jnp.tril(jnp.ones((CHUNK, CHUNK), dtype=bool))[:, :, None]

    def step(state, inp):
        qc, kc, vc, gc = inp
        b = jnp.cumsum(gc, axis=2)
        diff = b[:, :, :, None, :] - b[:, :, None, :, :]
        decay = jnp.where(causal, jnp.exp(jnp.where(causal, diff, 0.0)), 0.0)
        scores = jnp.einsum('bhtk,bhtsk,bhsk->bhts', qc, decay, kc)
        o = (jnp.einsum('bhts,bhsv->bhtv', scores, vc)
             + jnp.einsum('bhtk,bhkv->bhtv', qc * jnp.exp(b), state))
        b_last = b[:, :, -1:, :]
        state = (jnp.exp(b_last[:, :, 0, :, None]) * state
                 + jnp.einsum('bhsk,bhsv->bhkv', kc * jnp.exp(b_last - b), vc))
        return state, o

    s0 = jnp.zeros((B_, H, dk, dv), jnp.float32)
    _, o = lax.scan(step, s0, (to_chunks(q), to_chunks(k), to_chunks(v), to_chunks(log_f)))
    return o.transpose(1, 0, 3, 2, 4).reshape(B_, S_, H, dv)


def stick_breaking(q, k, v):
    S_ = q.shape[2]
    scale = B_DH ** -0.5
    outs = []
    for blk in range(S_ // Q_BLOCK):
        t0 = blk * Q_BLOCK
        t1 = t0 + Q_BLOCK
        z = jnp.einsum('bhtd,bhsd->bhts', q[:, :, t0:t1], k[:, :, :t1]) * scale
        mask = jnp.arange(t1)[None, :] < (t0 + jnp.arange(Q_BLOCK))[:, None]
        log_1m = jnp.where(mask, -jax.nn.softplus(z), 0.0)
        log_rest = lax.cumsum(log_1m, axis=3, reverse=True) - log_1m
        w = jnp.where(mask, jnp.exp(jax.nn.log_sigmoid(z) + log_rest), 0.0)
        outs.append(jnp.einsum('bhts,bhsd->bhtd', w, v[:, :, :t1]))
    return jnp.concatenate(outs, axis=2)


def mixer_layer(h, norm_g, w_in, a_norm_g, b_norm_g, w_out, lb):
    B_, S_, _ = h.shape
    f32 = jnp.float32
    u = rmsnorm(h, norm_g)
    proj = jnp.einsum('bsd,de->bse', u, w_in)
    a_q, a_f, a_i, a_g, b_q, b_k, b_v, b_g = jnp.split(
        proj, [int(c) for c in np.cumsum(IN_WIDTHS)[:-1]], axis=-1)

    lb = lb.astype(f32)
    k_a = (1.0 - lb) * jax.nn.sigmoid(-a_f.astype(f32))
    log_f = jnp.log1p(-k_a)
    q_a = jax.nn.silu(a_q.astype(f32))
    hd = lambda t, d: t.reshape(B_, S_, A_HEADS, d)
    o_a = hgrn2_chunkwise(hd(q_a, A_DK), hd(k_a, A_DK), hd(a_i.astype(f32), A_DV), hd(log_f, A_DK))
    o_a = head_rmsnorm(o_a, a_norm_g) * jax.nn.silu(a_g.astype(f32))

    to_heads = lambda t: t.astype(f32).reshape(B_, S_, B_HEADS, B_DH).transpose(0, 2, 1, 3)
    o_b = stick_breaking(to_heads(b_q), to_heads(b_k), to_heads(b_v)).transpose(0, 2, 1, 3)
    o_b = head_rmsnorm(o_b, b_norm_g) * jax.nn.silu(b_g.astype(f32))

    y = jnp.concatenate([o_a, o_b], axis=-1).astype(h.dtype)
    return h + jnp.einsum('bse,ed->bsd', y, w_out)


def setup_inputs(seed: int = 0) -> dict:
    key = jax.random.key(seed)
    ks = jax.random.split(key, 14)
    f32 = jnp.float32
    nrm = lambda k, shape, s: jax.random.normal(k, shape, f32) * s
    return {
        "x": nrm(ks[0], (BATCH, SEQ, D_MODEL), 1.0),
        "p": nrm(ks[1], (DEPTH, BATCH, SEQ, D_PLE), 1.0),
        "norm_mix": 1.0 + nrm(ks[2], (DEPTH, D_MODEL), 0.02),
        "w_in": nrm(ks[3], (DEPTH, D_MODEL, D_IN), D_MODEL ** -0.5),
        "a_out_norm": 1.0 + nrm(ks[4], (DEPTH, A_HEADS * A_DV), 0.02),
        "b_out_norm": 1.0 + nrm(ks[5], (DEPTH, B_WIDTH), 0.02),
        "w_out": nrm(ks[6], (DEPTH, D_MIX, D_MODEL), 0.5 * D_MIX ** -0.5),
        "lb_logits": nrm(ks[7], (DEPTH, A_WIDTH), 0.1),
        "ple_gate_norm": 1.0 + nrm(ks[8], (DEPTH, D_MODEL), 0.02),
        "w_ple_gate": nrm(ks[9], (DEPTH, D_MODEL, D_MODEL), D_MODEL ** -0.5),
        "w_ple_proj": nrm(ks[10], (DEPTH, D_PLE, D_MODEL), D_PLE ** -0.5),
        "ple_post_norm": 1.0 + nrm(ks[11], (DEPTH, D_MODEL), 0.02),
        "final_norm": 1.0 + nrm(ks[12], (D_MODEL,), 0.02),
    }


def reference(x, p, norm_mix, w_in, a_out_norm, b_out_norm, w_out, lb_logits,
              ple_gate_norm, w_ple_gate, w_ple_proj, ple_post_norm, final_norm):
    sm = jax.nn.softmax(lb_logits.astype(jnp.float32), axis=0)
    lower_bounds = jnp.cumsum(sm, axis=0) - sm[0:1]

    h = x
    for i in range(DEPTH):
        h = mixer_layer(h, norm_mix[i], w_in[i], a_out_norm[i], b_out_norm[i], w_out[i], lower_bounds[i])
        pe = rmsnorm(jnp.einsum('bsc,cd->bsd', p[i], w_ple_proj[i]), ple_post_norm[i])
        gate = jax.nn.sigmoid(jnp.einsum('bsd,de->bse', rmsnorm(h, ple_gate_norm[i]), w_ple_gate[i]))
        h = h + gate * pe
    return rmsnorm(h, final_norm)
```

```cpp
#include <hip/hip_runtime.h>
#include <hip/hip_cooperative_groups.h>
#include <cstdio>
#include <cstdint>
namespace cg = cooperative_groups;
#define MK_MULTI 0
namespace pg8 {
#define PG8_LAS __attribute__((address_space(3)))
typedef unsigned short bf16_t;
typedef short bf16x8 __attribute__((ext_vector_type(8)));
typedef float f32x4 __attribute__((ext_vector_type(4)));
typedef unsigned u32x4 __attribute__((ext_vector_type(4)));
constexpr int BM = 256, BK = 64, HALF = 128, HTB = HALF * BK * 2  , STAGE_BYTES = 8 * HTB, NXCD = 8, WGM = 8;

__host__ __device__ __forceinline__ int lds_byte(int r, int c) { const int st = (r >> 4) * 2 + (c >> 5), rr = r & 15, cc = c & 31, ob = rr * 64 + cc * 2; return st * 1024 + (ob ^ (((ob >> 9) & 1) << 5)); }
__host__ __device__ __forceinline__ void stage_rc(int b, int& R, int& C) { const int st = b / 1024, sb = b % 1024, swz = sb ^ (((sb >> 9) & 1) << 5); R = (st >> 1) * 16 + swz / 64; C = (st & 1) * 32 + (swz % 64) / 2; }
__host__ __device__ __forceinline__ int perm32(int rho) { const int n = rho >> 4, i = rho & 15; return 8 * (i >> 2) + 4 * n + (i & 3); }

struct Unit { int pm, pn; };
struct Gemm { const bf16_t* A; const bf16_t* Bt; int M, N, K; };

struct StaticOrder {
    int nM, nN, nwg, G, c;
    __host__ __device__ void init(int M, int N, int G_, int c_) { nM = M / BM; nN = N / BM; nwg = nM * nN; G = G_; c = c_; }
    __host__ __device__ bool next(int i, Unit& u) const {
        const long L = (long)i * G + c; if (L >= nwg) return false;
        int wgid = (int)L; { const int q = nwg / NXCD, r = nwg % NXCD, xcd = wgid % NXCD, off = wgid / NXCD; wgid = (xcd < r ? xcd * (q + 1) : r * (q + 1) + (xcd - r) * q) + off; }
        const int nig = WGM * nN, gid = wgid / nig, fm = gid * WGM, gsz = (nM - fm) < WGM ? (nM - fm) : WGM;
        u.pm = fm + ((wgid % nig) % gsz); u.pn = (wgid % nig) / gsz; return true;
    }
    __device__ __forceinline__ void a_ready(const Unit&) const {}
    __device__ __forceinline__ void done(const Unit&) const {}
};

__device__ __forceinline__ unsigned cvt_pk_bf16(float lo, float hi) { unsigned r; asm volatile("v_cvt_pk_bf16_f32 %0, %1, %2" : "=v"(r) : "v"(lo), "v"(hi)); return r; }
typedef float f32x2 __attribute__((ext_vector_type(2)));
template <class Epi, class Sched, bool ALIGN_EPI = false, bool SP2 = false>
__device__ __forceinline__ void gemm_phase(PG8_LAS unsigned char* lds, const Gemm g, const Sched& S, const Epi& E) {
    int tid_ = threadIdx.x; asm volatile("" : "+v"(tid_));
    const int tid = tid_, wid = __builtin_amdgcn_readfirstlane(tid >> 6), lane = tid & 63, wr = wid >> 2, wc = wid & 3, fr = lane & 15, fq = lane >> 4;
    const int K = g.K, nt = K / BK;
    unsigned voffA[2], voffB[2];
#pragma unroll
    for (int i = 0; i < 2; ++i) { int R, C; stage_rc(tid * 16 + i * 8192, R, C); const int Rb = Epi::PERM ? ((R & ~31) + perm32(R & 31)) : R;
        voffA[i] = (unsigned)(R * K + C) * 2u; voffB[i] = (unsigned)(Rb * K + C) * 2u; }
    const size_t kstep = (size_t)(BK * 2);
    const size_t hstep = (size_t)HALF * K * 2;
    const size_t tstep = 2 * hstep;
    const unsigned ldsw = (unsigned)wid * 1024u;
    const int aoff = lds_byte(wr * 64 + fr, fq * 8), boff = lds_byte(wc * 32 + fr, fq * 8);
#define PG8_SA(b, h) (((b) * 2 + (h)) * HTB)
#define PG8_SB(b, h) ((4 + (b) * 2 + (h)) * HTB)
#define PG8_STAGE(bufoff, gbase, voff) do { _Pragma("unroll") for (int _i = 0; _i < 2; ++_i) \
        __builtin_amdgcn_global_load_lds((const unsigned*)((const char*)(gbase) + (voff)[_i]), (PG8_LAS unsigned*)(lds + (bufoff) + ldsw + _i * 8192), 16, 0, 0); } while (0)
#define PG8_LDA(dst, b, h) do { _Pragma("unroll") for (int m = 0; m < 4; ++m) _Pragma("unroll") for (int k = 0; k < 2; ++k) dst[m][k] = *(const PG8_LAS bf16x8*)(lds + PG8_SA(b, h) + aoff + m * 2048 + k * 1024); } while (0)
#define PG8_LDB(dst, b, h) do { _Pragma("unroll") for (int n = 0; n < 2; ++n) _Pragma("unroll") for (int k = 0; k < 2; ++k) dst[n][k] = *(const PG8_LAS bf16x8*)(lds + PG8_SB(b, h) + boff + n * 2048 + k * 1024); } while (0)
#define PG8_MMA(ai, bj, At, Bt) do { __builtin_amdgcn_s_setprio(1); _Pragma("unroll") for (int m = 0; m < 4; ++m) _Pragma("unroll") for (int n = 0; n < 2; ++n) _Pragma("unroll") for (int k = 0; k < 2; ++k) \
        acc[ai][bj][m][n] = __builtin_amdgcn_mfma_f32_16x16x32_bf16(Bt[n][k], At[m][k], acc[ai][bj][m][n], 0, 0, 0); __builtin_amdgcn_s_setprio(0); } while (0)
#define PG8_WAIT_V(n) asm volatile("s_waitcnt vmcnt(" #n ")" ::: "memory")
#define PG8_WAIT_L(n) asm volatile("s_waitcnt lgkmcnt(" #n ")" ::: "memory")
#define PG8_BAR __builtin_amdgcn_s_barrier()
#define PG8_SCHED __builtin_amdgcn_sched_barrier(0)
    Unit cur, nxt; int ui = 0;
    if (!S.next(0, cur)) return;
    f32x4 acc[2][2][4][2];
#pragma unroll
    for (int a = 0; a < 2; ++a)
#pragma unroll
        for (int b = 0; b < 2; ++b)
#pragma unroll
            for (int m = 0; m < 4; ++m)
#pragma unroll
                for (int n = 0; n < 2; ++n) acc[a][b][m][n] = (f32x4){0.f, 0.f, 0.f, 0.f};
    bf16x8 At[4][2], B0[2][2], B1[2][2];
    const char* cA = (const char*)g.A + (size_t)cur.pm * tstep; const char* cB = (const char*)g.Bt + (size_t)cur.pn * tstep;
    S.a_ready(cur);
    if constexpr (SP2) {
        PG8_STAGE(PG8_SB(0, 0), cB, voffB); PG8_STAGE(PG8_SB(0, 1), cB + hstep, voffB); PG8_STAGE(PG8_SA(0, 0), cA, voffA); PG8_STAGE(PG8_SA(0, 1), cA + hstep, voffA);
        if (wr == 1) PG8_BAR;
        PG8_WAIT_V(2); PG8_BAR;
        PG8_STAGE(PG8_SB(1, 0), cB + kstep, voffB); PG8_STAGE(PG8_SA(1, 0), cA + kstep, voffA); PG8_STAGE(PG8_SB(1, 1), cB + hstep + kstep, voffB);
        PG8_WAIT_V(6); PG8_BAR;
    } else {
        PG8_STAGE(PG8_SB(0, 0), cB, voffB); PG8_STAGE(PG8_SA(0, 0), cA, voffA); PG8_STAGE(PG8_SB(0, 1), cB + hstep, voffB); PG8_STAGE(PG8_SA(0, 1), cA + hstep, voffA);
        if (wr == 1) PG8_BAR;
        PG8_WAIT_V(4); PG8_BAR;
        PG8_STAGE(PG8_SB(1, 0), cB + kstep, voffB); PG8_STAGE(PG8_SA(1, 0), cA + kstep, voffA); PG8_STAGE(PG8_SB(1, 1), cB + hstep + kstep, voffB);
        PG8_WAIT_V(6); PG8_BAR;
    }
    for (;;) {
        const bool has_next = S.next(ui + 1, nxt);
        const char* nA = has_next ? (const char*)g.A + (size_t)nxt.pm * tstep : cA; const char* nB = has_next ? (const char*)g.Bt + (size_t)nxt.pn * tstep : cB;
        for (int t = 0; t < nt; t += 2) {
            const bool last = (t == nt - 2);
            const char* a1 = cA + (size_t)(t + 1) * kstep;
            const char* a2 = last ? nA : cA + (size_t)(t + 2) * kstep; const char* b2 = last ? nB : cB + (size_t)(t + 2) * kstep;
            const char* a3 = a2 + kstep; const char* b3 = b2 + kstep;
            if (last && has_next) S.a_ready(nxt);
            if constexpr (SP2) {
            PG8_LDB(B0, 0, 0); PG8_LDB(B1, 0, 1); PG8_SCHED; PG8_LDA(At, 0, 0); PG8_STAGE(PG8_SA(1, 1), a1 + hstep, voffA);
            PG8_WAIT_V(8); PG8_WAIT_L(0); PG8_BAR; PG8_MMA(0, 0, At, B0); PG8_MMA(0, 1, At, B1); PG8_BAR; PG8_SCHED;
            PG8_LDA(At, 0, 1); PG8_STAGE(PG8_SB(0, 0), b2, voffB); PG8_STAGE(PG8_SB(0, 1), b2 + hstep, voffB); PG8_STAGE(PG8_SA(0, 0), a2, voffA);
            PG8_WAIT_V(8); PG8_WAIT_L(0); PG8_BAR; PG8_MMA(1, 0, At, B0); PG8_MMA(1, 1, At, B1); PG8_BAR; PG8_SCHED;
            PG8_LDB(B0, 1, 0); PG8_LDB(B1, 1, 1); PG8_SCHED; PG8_LDA(At, 1, 0); PG8_STAGE(PG8_SA(0, 1), a2 + hstep, voffA);
            PG8_WAIT_V(8); PG8_WAIT_L(0); PG8_BAR; PG8_MMA(0, 0, At, B0); PG8_MMA(0, 1, At, B1); PG8_BAR; PG8_SCHED;
            PG8_LDA(At, 1, 1); PG8_STAGE(PG8_SB(1, 0), b3, voffB); PG8_STAGE(PG8_SB(1, 1), b3 + hstep, voffB); PG8_STAGE(PG8_SA(1, 0), a3, voffA);
            PG8_WAIT_V(8); PG8_WAIT_L(0); PG8_BAR; PG8_MMA(1, 0, At, B0); PG8_MMA(1, 1, At, B1); PG8_BAR; PG8_SCHED;
            } else {
            PG8_LDB(B0, 0, 0); PG8_SCHED; PG8_LDA(At, 0, 0); PG8_STAGE(PG8_SA(1, 1), a1 + hstep, voffA);
            PG8_WAIT_L(8); PG8_BAR; PG8_WAIT_L(0); PG8_MMA(0, 0, At, B0); PG8_BAR; PG8_SCHED;
            PG8_LDB(B1, 0, 1); PG8_STAGE(PG8_SB(0, 0), b2, voffB);
            PG8_BAR; PG8_WAIT_L(0); PG8_MMA(0, 1, At, B1); PG8_BAR;
            PG8_LDA(At, 0, 1); PG8_STAGE(PG8_SA(0, 0), a2, voffA);
            PG8_BAR; PG8_WAIT_L(0); PG8_MMA(1, 0, At, B0); PG8_BAR; PG8_SCHED;
            PG8_STAGE(PG8_SB(0, 1), b2 + hstep, voffB);
            PG8_WAIT_V(6); PG8_BAR; PG8_MMA(1, 1, At, B1); PG8_BAR;
            PG8_LDB(B0, 1, 0); PG8_SCHED; PG8_LDA(At, 1, 0); PG8_STAGE(PG8_SA(0, 1), a2 + hstep, voffA);
            PG8_WAIT_L(8); PG8_BAR; PG8_WAIT_L(0); PG8_MMA(0, 0, At, B0); PG8_BAR; PG8_SCHED;
            PG8_LDB(B1, 1, 1); PG8_STAGE(PG8_SB(1, 0), b3, voffB);
            PG8_BAR; PG8_WAIT_L(0); PG8_MMA(0, 1, At, B1); PG8_BAR;
            PG8_LDA(At, 1, 1); PG8_STAGE(PG8_SA(1, 0), a3, voffA);
            PG8_BAR; PG8_WAIT_L(0); PG8_MMA(1, 0, At, B0); PG8_BAR; PG8_SCHED;
            PG8_STAGE(PG8_SB(1, 1), b3 + hstep, voffB);
            PG8_WAIT_V(6); PG8_BAR; PG8_MMA(1, 1, At, B1); PG8_BAR;
            }
        }
        if constexpr (ALIGN_EPI) { if (wr == 0) PG8_BAR; }
        if constexpr (!Epi::AFTER_DRAIN) { E(acc, cur, wr, wc, fr, fq); S.done(cur); }
        if (!has_next) break;
#pragma unroll
        for (int a = 0; a < 2; ++a)
#pragma unroll
            for (int b = 0; b < 2; ++b)
#pragma unroll
                for (int m = 0; m < 4; ++m)
#pragma unroll
                    for (int n = 0; n < 2; ++n) acc[a][b][m][n] = (f32x4){0.f, 0.f, 0.f, 0.f};
        cur = nxt; cA = nA; cB = nB; ++ui;
        if constexpr (ALIGN_EPI) { if (wr == 1) PG8_BAR; }
    }
    PG8_WAIT_V(0);
    if constexpr (!ALIGN_EPI) { if (wr == 0) PG8_BAR; }
    PG8_BAR;
    if constexpr (Epi::AFTER_DRAIN) { E.fused(acc, cur, wr, wc, fr, fq, lds, wid, lane); S.done(cur); }
#undef PG8_SA
#undef PG8_SB
#undef PG8_STAGE
#undef PG8_LDA
#undef PG8_LDB
#undef PG8_MMA
#undef PG8_WAIT_V
#undef PG8_WAIT_L
#undef PG8_BAR
#undef PG8_SCHED
}
}

constexpr int BATCH = 8, SEQ = 4096, DM = 1024, MTOK = BATCH * SEQ, DEPTH = 2, DIN = 4096, DPLE = 256;
constexpr float EPS = 1e-6f;
constexpr float LOG2E = 1.4426950408889634f;
constexpr float QSCALE = 0.125f * LOG2E;
#define LAS __attribute__((address_space(3)))
typedef unsigned short u16;
typedef short s8v __attribute__((ext_vector_type(8)));
typedef short s4v __attribute__((ext_vector_type(4)));
typedef _Float16 h8v __attribute__((ext_vector_type(8)));
typedef _Float16 h2v __attribute__((ext_vector_type(2)));
typedef float f32x2 __attribute__((ext_vector_type(2)));
typedef float f32x4 __attribute__((ext_vector_type(4)));
typedef float f32x16 __attribute__((ext_vector_type(16)));
typedef unsigned u32x4 __attribute__((ext_vector_type(4)));
typedef unsigned u32x2 __attribute__((ext_vector_type(2)));

constexpr size_t MiB = 1u << 20;
constexpr size_t WS_CTL = 0, CTL_BYTES = 1 * MiB;
constexpr size_t WS_WIN = 1 * MiB;
constexpr size_t WS_WOUT = 17 * MiB;
constexpr size_t WS_WG = 21 * MiB;
constexpr size_t WS_WP = 25 * MiB;
constexpr size_t WS_SMALL = 26 * MiB;
constexpr size_t WS_PB = 27 * MiB;
constexpr size_t WS_X0 = 59 * MiB, WS_X1 = 123 * MiB;
constexpr size_t WS_PROJ = 187 * MiB;
constexpr size_t WS_PE = 443 * MiB;
constexpr size_t WS_EBL = 507 * MiB;
constexpr size_t WS_END = 509 * MiB;
constexpr size_t CTL_SSQ = 65536;
constexpr size_t SEGSZ = (size_t)MTOK * 512;
constexpr int LDS_BYTES = 148480;
constexpr int NPHASE = 12;
#define ATT_THR -150.f

__device__ __forceinline__ float bf2f(u16 u) { return __uint_as_float((unsigned)u << 16); }
__device__ __forceinline__ float h2f(u16 u) { return (float)__builtin_bit_cast(_Float16, u); }
__device__ __forceinline__ unsigned pkbf(float lo, float hi) { unsigned r; asm volatile("v_cvt_pk_bf16_f32 %0, %1, %2" : "=v"(r) : "v"(lo), "v"(hi)); return r; }
__device__ __forceinline__ u16 f2bf(float f) { return (u16)(pkbf(f, 0.f) & 0xffffu); }
__device__ __forceinline__ unsigned pkh(float lo, float hi) { h2v v = {(_Float16)lo, (_Float16)hi}; return __builtin_bit_cast(unsigned, v); }
__device__ __forceinline__ float ex2(float x) { return __builtin_amdgcn_exp2f(x); }
__device__ __forceinline__ float lg2(float x) { return __builtin_amdgcn_logf(x); }
__device__ __forceinline__ float fmin120(float a) { float r; asm("v_min_f32 %0, 0x42f00000, %1" : "=v"(r) : "v"(a)); return r; }
__device__ __forceinline__ float sigmoid_f(float v) { return __builtin_amdgcn_rcpf(1.f + ex2(-v * LOG2E)); }
__device__ __forceinline__ float silu_f(float v) { return v * sigmoid_f(v); }
__device__ __forceinline__ float rstd_of(float ssq, float n) { return __builtin_amdgcn_rsqf(ssq * (1.f / n) + EPS); }

struct EpiProj {
    static constexpr bool PERM = true, AFTER_DRAIN = false;
    const float* ssq; const float* lbv; u16* proj;
    __device__ __forceinline__ void operator()(const pg8::f32x4 (&acc)[2][2][4][2], const pg8::Unit& u, int wr, int wc, int fr, int fq) const {
        const int seg = u.pn >> 1;
        u16* dst = proj + (size_t)seg * SEGSZ;
        const int cb = (u.pn & 1) * 256 + wc * 32 + 8 * fq;
        const bool isf16 = (seg == 1) | (seg == 4) | (seg == 5) | (seg == 6);
        const bool tr = (seg == 2) | (seg == 6);
        const bool dosilu = (seg == 0) | (seg == 3) | (seg == 7);
        float lb8[2][8];
#pragma unroll
        for (int bj = 0; bj < 2; ++bj)
#pragma unroll
            for (int j = 0; j < 8; ++j) lb8[bj][j] = (seg == 1) ? lbv[cb + bj * 128 + j] : 1.f;
        float rsv[2][4];
#pragma unroll
        for (int ai = 0; ai < 2; ++ai)
#pragma unroll
            for (int m = 0; m < 4; ++m) rsv[ai][m] = ssq[u.pm * 256 + ai * 128 + wr * 64 + m * 16 + fr];
#pragma unroll
        for (int ai = 0; ai < 2; ++ai)
#pragma unroll
            for (int m = 0; m < 4; ++m) {
                const int row = u.pm * 256 + ai * 128 + wr * 64 + m * 16 + fr;
                const float rs = rstd_of(rsv[ai][m], 1024.f);
#pragma unroll
                for (int bj = 0; bj < 2; ++bj) {
                    float v[8];
#pragma unroll
                    for (int n = 0; n < 2; ++n)
#pragma unroll
                        for (int j = 0; j < 4; ++j) v[4 * n + j] = acc[ai][bj][m][n][j] * rs;
                    if (dosilu) {
#pragma unroll
                        for (int j = 0; j < 8; ++j) v[j] = silu_f(v[j]);
                    } else if (seg == 1) {
#pragma unroll
                        for (int j = 0; j < 8; ++j) v[j] = fminf(lb8[bj][j] * sigmoid_f(-v[j]), 0.9995f);
                    } else if (seg == 4) {
#pragma unroll
                        for (int j = 0; j < 8; ++j) v[j] *= QSCALE;
                    }
                    u32x4 w;
                    if (isf16) { w.x = pkh(v[0], v[1]); w.y = pkh(v[2], v[3]); w.z = pkh(v[4], v[5]); w.w = pkh(v[6], v[7]); }
                    else { w.x = pkbf(v[0], v[1]); w.y = pkbf(v[2], v[3]); w.z = pkbf(v[4], v[5]); w.w = pkbf(v[6], v[7]); }
                    if (!tr) { *(u32x4*)(dst + (size_t)row * 512 + cb + bj * 128) = w; }
                    else {
                        u16* p = dst + ((size_t)((row >> 12) * 512 + cb + bj * 128)) * SEQ + (row & 4095);
                        p[0 * SEQ] = (u16)(w.x & 0xffffu); p[1 * SEQ] = (u16)(w.x >> 16); p[2 * SEQ] = (u16)(w.y & 0xffffu); p[3 * SEQ] = (u16)(w.y >> 16);
                        p[4 * SEQ] = (u16)(w.z & 0xffffu); p[5 * SEQ] = (u16)(w.z >> 16); p[6 * SEQ] = (u16)(w.w & 0xffffu); p[7 * SEQ] = (u16)(w.w >> 16);
                    }
                }
            }
    }
};
struct EpiPe {
    static constexpr bool PERM = true, AFTER_DRAIN = false;
    u16* pe; float* ssq;
    __device__ __forceinline__ void operator()(const pg8::f32x4 (&acc)[2][2][4][2], const pg8::Unit& u, int wr, int wc, int fr, int fq) const {
        const int cb = u.pn * 256 + wc * 32 + 8 * fq;
#pragma unroll
        for (int ai = 0; ai < 2; ++ai)
#pragma unroll
            for (int m = 0; m < 4; ++m) {
                const int row = u.pm * 256 + ai * 128 + wr * 64 + m * 16 + fr; float s = 0.f;
#pragma unroll
                for (int bj = 0; bj < 2; ++bj) {
                    const pg8::f32x4 a0 = acc[ai][bj][m][0], a1 = acc[ai][bj][m][1];
                    s += (a0[0] * a0[0] + a0[1] * a0[1]) + (a0[2] * a0[2] + a0[3] * a0[3]) + (a1[0] * a1[0] + a1[1] * a1[1]) + (a1[2] * a1[2] + a1[3] * a1[3]);
                    u32x4 w; w.x = pkbf(a0[0], a0[1]); w.y = pkbf(a0[2], a0[3]); w.z = pkbf(a1[0], a1[1]); w.w = pkbf(a1[2], a1[3]);
                    *(u32x4*)(pe + (size_t)row * 1024 + cb + bj * 128) = w;
                }
                s += __shfl_xor(s, 16); s += __shfl_xor(s, 32);
                if (fq == 0) atomicAdd(ssq + row, s);
            }
    }
};
__device__ __forceinline__ void unpack8(const u32x4 w, f32x4& a0, f32x4& a1) {
    a0[0] = __uint_as_float(w.x << 16); a0[1] = __uint_as_float(w.x & 0xffff0000u); a0[2] = __uint_as_float(w.y << 16); a0[3] = __uint_as_float(w.y & 0xffff0000u);
    a1[0] = __uint_as_float(w.z << 16); a1[1] = __uint_as_float(w.z & 0xffff0000u); a1[2] = __uint_as_float(w.w << 16); a1[3] = __uint_as_float(w.w & 0xffff0000u);
}
struct EpiH1 {
    static constexpr bool PERM = true, AFTER_DRAIN = false;
    u16* hb; float* ssq;
    __device__ __forceinline__ void operator()(const pg8::f32x4 (&acc)[2][2][4][2], const pg8::Unit& u, int wr, int wc, int fr, int fq) const {
        const int cb = u.pn * 256 + wc * 32 + 8 * fq;
#pragma unroll
        for (int ai = 0; ai < 2; ++ai) {
            u32x4 hv[4][2];
#pragma unroll
            for (int m = 0; m < 4; ++m)
#pragma unroll
                for (int bj = 0; bj < 2; ++bj) hv[m][bj] = *(const u32x4*)(hb + (size_t)(u.pm * 256 + ai * 128 + wr * 64 + m * 16 + fr) * 1024 + cb + bj * 128);
#pragma unroll
            for (int m = 0; m < 4; ++m) {
                const int row = u.pm * 256 + ai * 128 + wr * 64 + m * 16 + fr; float s = 0.f;
#pragma unroll
                for (int bj = 0; bj < 2; ++bj) {
                    f32x4 a0, a1; unpack8(hv[m][bj], a0, a1);
                    a0 = a0 + acc[ai][bj][m][0]; a1 = a1 + acc[ai][bj][m][1];
                    s += (a0[0] * a0[0] + a0[1] * a0[1]) + (a0[2] * a0[2] + a0[3] * a0[3]) + (a1[0] * a1[0] + a1[1] * a1[1]) + (a1[2] * a1[2] + a1[3] * a1[3]);
                    u32x4 w; w.x = pkbf(a0[0], a0[1]); w.y = pkbf(a0[2], a0[3]); w.z = pkbf(a1[0], a1[1]); w.w = pkbf(a1[2], a1[3]);
                    *(u32x4*)(hb + (size_t)row * 1024 + cb + bj * 128) = w;
                }
                s += __shfl_xor(s, 16); s += __shfl_xor(s, 32);
                if (fq == 0) atomicAdd(ssq + row, s);
            }
        }
    }
};
struct EpiGate {
    static constexpr bool PERM = true, AFTER_DRAIN = false;
    const float* ssq1; const float* ssqpe; const float* gpost; const u16* pe; const u16* hin; u16* hb; float* ssq2;
    __device__ __forceinline__ void operator()(const pg8::f32x4 (&acc)[2][2][4][2], const pg8::Unit& u, int wr, int wc, int fr, int fq) const {
        const int cb = u.pn * 256 + wc * 32 + 8 * fq;
        f32x4 gp[2][2];
#pragma unroll
        for (int bj = 0; bj < 2; ++bj) { gp[bj][0] = *(const f32x4*)(gpost + cb + bj * 128); gp[bj][1] = *(const f32x4*)(gpost + cb + bj * 128 + 4); }
#pragma unroll
        for (int ai = 0; ai < 2; ++ai)
#pragma unroll
            for (int mp = 0; mp < 2; ++mp) {
                u32x4 hv[2][2], pv[2][2]; float r1[2], rp[2];
#pragma unroll
                for (int mm = 0; mm < 2; ++mm) { const int row = u.pm * 256 + ai * 128 + wr * 64 + (2 * mp + mm) * 16 + fr; r1[mm] = ssq1[row]; rp[mm] = ssqpe[row]; }
#pragma unroll
                for (int mm = 0; mm < 2; ++mm)
#pragma unroll
                    for (int bj = 0; bj < 2; ++bj) {
                        const size_t off = (size_t)(u.pm * 256 + ai * 128 + wr * 64 + (2 * mp + mm) * 16 + fr) * 1024 + cb + bj * 128;
                        hv[mm][bj] = *(const u32x4*)(hin + off); pv[mm][bj] = *(const u32x4*)(pe + off);
                    }
#pragma unroll
                for (int mm = 0; mm < 2; ++mm) {
                    const int m = 2 * mp + mm, row = u.pm * 256 + ai * 128 + wr * 64 + m * 16 + fr; float s = 0.f;
                    const float rs1 = rstd_of(r1[mm], 1024.f), rsp = rstd_of(rp[mm], 1024.f);
#pragma unroll
                    for (int bj = 0; bj < 2; ++bj) {
                        f32x4 a0, a1, p0, p1; unpack8(hv[mm][bj], a0, a1); unpack8(pv[mm][bj], p0, p1);
#pragma unroll
                        for (int j = 0; j < 4; ++j) {
                            a0[j] += sigmoid_f(acc[ai][bj][m][0][j] * rs1) * (p0[j] * rsp * gp[bj][0][j]);
                            a1[j] += sigmoid_f(acc[ai][bj][m][1][j] * rs1) * (p1[j] * rsp * gp[bj][1][j]);
                        }
                        s += (a0[0] * a0[0] + a0[1] * a0[1]) + (a0[2] * a0[2] + a0[3] * a0[3]) + (a1[0] * a1[0] + a1[1] * a1[1]) + (a1[2] * a1[2] + a1[3] * a1[3]);
                        u32x4 w; w.x = pkbf(a0[0], a0[1]); w.y = pkbf(a0[2], a0[3]); w.z = pkbf(a1[0], a1[1]); w.w = pkbf(a1[2], a1[3]);
                        *(u32x4*)(hb + (size_t)row * 1024 + cb + bj * 128) = w;
                    }
                    s += __shfl_xor(s, 16); s += __shfl_xor(s, 32);
                    if (fq == 0) atomicAdd(ssq2 + row, s);
                }
            }
    }
};
__device__ __forceinline__ float wave_sum(float v) {
#pragma unroll
    for (int o = 1; o < 64; o <<= 1) v += __shfl_xor(v, o);
    return v;
}
__device__ __forceinline__ void p0_transpose_item(const float* W, int K, int N, u16* WT, const float* scA, const float* scB, int split, LAS float* scr, int item, int lane) {
    const int nblk = N / 32, kb = item / nblk, nb = item % nblk, k0 = 64 * kb, n0 = 32 * nb;
    const int kr = lane >> 3, nc = (lane & 7) * 4;
    f32x4 v[8]; float sc[8];
#pragma unroll
    for (int i = 0; i < 8; ++i) { const int k = k0 + 8 * i + kr; v[i] = *(const f32x4*)(W + (size_t)k * N + n0 + nc); sc[i] = scA ? (k < split ? scA[k] : scB[k - split]) : 1.f; }
#pragma unroll
    for (int i = 0; i < 8; ++i) { LAS float* d = scr + (8 * i + kr) * 33 + nc; d[0] = v[i][0] * sc[i]; d[1] = v[i][1] * sc[i]; d[2] = v[i][2] * sc[i]; d[3] = v[i][3] * sc[i]; }
    asm volatile("s_waitcnt lgkmcnt(0)" ::: "memory");
    const int c = lane & 7;
#pragma unroll
    for (int j = 0; j < 4; ++j) {
        const int n = (lane >> 3) + 8 * j; const LAS float* s = scr + (8 * c) * 33 + n;
        u32x4 o; o.x = pkbf(s[0 * 33], s[1 * 33]); o.y = pkbf(s[2 * 33], s[3 * 33]); o.z = pkbf(s[4 * 33], s[5 * 33]); o.w = pkbf(s[6 * 33], s[7 * 33]);
        *(u32x4*)(WT + (size_t)(n0 + n) * K + k0 + 8 * c) = o;
    }
    asm volatile("s_waitcnt lgkmcnt(0)" ::: "memory");
}

__device__ __forceinline__ int crow(int r, int hi) { return (r & 3) + 8 * (r >> 2) + 4 * hi; }
#define MFMA32H(a, b, c) __builtin_amdgcn_mfma_f32_32x32x16_f16((a), (b), (c), 0, 0, 0)
__device__ __forceinline__ void attn_unit(int unit, LAS unsigned char* wl  , const u16* QBp, const u16* KBp, const u16* VBT, const u16* GBp, u16* Y) {
    int tid_ = threadIdx.x; asm volatile("" : "+v"(tid_));
    const int lane = tid_ & 63, q = lane & 31, hi = lane >> 5;
    const int bh = unit >> 7, qb = unit & 127, b = bh >> 3, h = bh & 7, t0 = qb * 32;
    const size_t rb = (size_t)b * SEQ;
    const u16* Qp = QBp + (rb + t0 + q) * 512 + h * 64 + 8 * hi;
    h8v qf[4];
#pragma unroll
    for (int c = 0; c < 4; ++c) qf[c] = *(const h8v*)(Qp + 16 * c);
    u32x2 gtw[2][4];
#pragma unroll
    for (int db = 0; db < 2; ++db)
#pragma unroll
        for (int r4 = 0; r4 < 4; ++r4) gtw[db][r4] = *(const u32x2*)(GBp + (rb + t0 + q) * 512 + h * 64 + 32 * db + 8 * r4 + 4 * hi);
    const u16* Kp = KBp + (rb + (lane >> 3)) * 512 + h * 64 + 8 * (lane & 7);
    const u16* Vp = VBT + ((size_t)(b * 512 + h * 64 + (lane >> 3))) * SEQ + 8 * (lane & 7);
    constexpr int AP = 144, AV = 64 * AP;
    LAS unsigned char* wst = wl + (lane >> 3) * AP + (lane & 7) * 16;
    const LAS unsigned char* kfr = wl + q * AP + 16 * hi;
    const LAS unsigned char* vfr = wl + AV + q * AP + 8 * hi;
    h8v um1;
#pragma unroll
    for (int i = 0; i < 8; ++i) um1[i] = (_Float16)(-1.f);
    f32x16 ot[2];
#pragma unroll
    for (int r = 0; r < 16; ++r) { ot[0][r] = 0.f; ot[1][r] = 0.f; }
    float R = 0.f;
#define ATT_LOADK(KR, KT) do { _Pragma("unroll") for (int i = 0; i < 8; ++i) KR[i] = *(const u32x4*)(Kp + (size_t)((KT) + 8 * i) * 512); } while (0)
#define ATT_LOADV(VR, KT) do { _Pragma("unroll") for (int i = 0; i < 8; ++i) VR[i] = *(const u32x4*)(Vp + (size_t)(8 * i) * SEQ + (KT)); } while (0)
    u32x4 kraw[8], vraw[8];
    int kt = t0 & ~63;
    ATT_LOADK(kraw, kt);
    for (;;) {
        const int ktn = kt - 64;
        ATT_LOADV(vraw, kt);
#pragma unroll
        for (int i = 0; i < 8; ++i) *(LAS u32x4*)(wst + i * 8 * AP) = kraw[i];
        if (ktn >= 0) ATT_LOADK(kraw, ktn);
        h8v kf[2][4];
#pragma unroll
        for (int blk = 0; blk < 2; ++blk)
#pragma unroll
            for (int c = 0; c < 4; ++c) kf[blk][c] = *(const LAS h8v*)(kfr + blk * 32 * AP + 32 * c);
        f32x16 sb[2];
#pragma unroll
        for (int blk = 0; blk < 2; ++blk) {
            f32x16 a;
#pragma unroll
            for (int r = 0; r < 16; ++r) a[r] = 0.f;
#pragma unroll
            for (int c = 0; c < 4; ++c) a = MFMA32H(kf[blk][c], qf[c], a);
            sb[blk] = a;
        }
        const bool diag = (kt + 64 > t0);
        const float tsave = sb[0][0];
        h8v lh[2][2];
#define ATT_SOFTPLUS(DIAG) do { _Pragma("unroll") for (int blk = 0; blk < 2; ++blk) _Pragma("unroll") for (int r = 0; r < 16; ++r) { \
            float l = lg2(1.f + ex2(fmin120(sb[blk][r]))); \
            if (DIAG) { if (kt + 32 * blk + crow(r, hi) >= t0 + q) l = 0.f; } \
            lh[blk][r >> 3][r & 7] = (_Float16)l; } } while (0)
        if (diag) { ATT_SOFTPLUS(1); } else { ATT_SOFTPLUS(0); }
#undef ATT_SOFTPLUS
        f32x16 c0 = sb[0], c1 = sb[1];
        h8v ud[2];
        { int qo = q; asm volatile("" : "+v"(qo));
#pragma unroll
          for (int cc = 0; cc < 2; ++cc)
#pragma unroll
            for (int i = 0; i < 8; ++i) ud[cc][i] = (crow(8 * cc + i, hi) >= qo) ? (_Float16)(-1.f) : (_Float16)0.f; }
        c0 = MFMA32H(ud[0], lh[0][0], c0); c0 = MFMA32H(ud[1], lh[0][1], c0); c0 = MFMA32H(um1, lh[1][0], c0); c0 = MFMA32H(um1, lh[1][1], c0);
        c1 = MFMA32H(ud[0], lh[1][0], c1); c1 = MFMA32H(ud[1], lh[1][1], c1);
        h8v wh[2][2];
#define ATT_WEIGHTS(DIAG) do { _Pragma("unroll") for (int r = 0; r < 16; ++r) { \
            float w0 = ex2(c0[r] + R), w1 = ex2(c1[r] + R); \
            if (DIAG) { if (kt + crow(r, hi) >= t0 + q) w0 = 0.f; if (kt + 32 + crow(r, hi) >= t0 + q) w1 = 0.f; } \
            wh[0][r >> 3][r & 7] = (_Float16)w0; wh[1][r >> 3][r & 7] = (_Float16)w1; } } while (0)
        if (diag) { ATT_WEIGHTS(1); } else { ATT_WEIGHTS(0); }
#undef ATT_WEIGHTS
        float tot = tsave - c0[0];
        tot = __shfl(tot, q);
        R -= tot;
#pragma unroll
        for (int i = 0; i < 8; ++i) *(LAS u32x4*)(wst + AV + i * 8 * AP) = vraw[i];
#pragma unroll
        for (int db = 0; db < 2; ++db)
#pragma unroll
            for (int blk = 0; blk < 2; ++blk)
#pragma unroll
                for (int cc = 0; cc < 2; ++cc) {
                    const LAS unsigned char* vp_ = vfr + db * 32 * AP + 64 * blk + 32 * cc;
                    const s4v lo_ = *(const LAS s4v*)vp_, hh_ = *(const LAS s4v*)(vp_ + 16);
                    ot[db] = MFMA32H(__builtin_bit_cast(h8v, __builtin_shufflevector(lo_, hh_, 0, 1, 2, 3, 4, 5, 6, 7)), wh[blk][cc], ot[db]);
                }
        if (ktn < 0 || !__any(R > ATT_THR)) break;
        kt = ktn;
    }
#undef ATT_LOADK
#undef ATT_LOADV
    float ss = 0.f;
#pragma unroll
    for (int r = 0; r < 16; ++r) ss += ot[0][r] * ot[0][r] + ot[1][r] * ot[1][r];
    ss += __shfl_xor(ss, 32);
    const float rs = rstd_of(ss, 64.f);
    const size_t row = rb + t0 + q;
#pragma unroll
    for (int db = 0; db < 2; ++db)
#pragma unroll
        for (int r4 = 0; r4 < 4; ++r4) {
            const int d = 32 * db + 8 * r4 + 4 * hi;
            const u32x2 gw = gtw[db][r4];
            const float g0 = __uint_as_float(gw.x << 16), g1 = __uint_as_float(gw.x & 0xffff0000u), g2 = __uint_as_float(gw.y << 16), g3 = __uint_as_float(gw.y & 0xffff0000u);
            u32x2 o; o.x = pkbf(ot[db][4 * r4 + 0] * rs * g0, ot[db][4 * r4 + 1] * rs * g1); o.y = pkbf(ot[db][4 * r4 + 2] * rs * g2, ot[db][4 * r4 + 3] * rs * g3);
            *(u32x2*)(Y + row * 1024 + 512 + h * 64 + d) = o;
        }
}

#define MFMA16B(a, b, c) __builtin_amdgcn_mfma_f32_16x16x32_bf16((a), (b), (c), 0, 0, 0)
constexpr int SC_QT = 0, SC_KT = 17408, SC_KTT = 34816, SC_PP = 53248, SC_FAC = 62464, SC_BSEG = 64000, SC_SSQ = 66048;
constexpr int SC_QP = 272, SC_TP = 144;
constexpr int NUNIT = BATCH * 4 * (SEQ / 64);

constexpr int SC_BSEG2 = 64000, SC_SSQ2 = 68096;
__device__ __forceinline__ void scanA_all(int bx, int G, LAS unsigned char* lds, const u16* KA, const u16* VAT, unsigned long long* UBUF, float* EBL) {
    int tid_ = threadIdx.x; asm volatile("" : "+v"(tid_));
    const int tid = tid_, lane = tid & 63, w = __builtin_amdgcn_readfirstlane(tid >> 6), l15 = lane & 15, g = lane >> 4, kp = lane;
    LAS float* FAC = (LAS float*)(lds + SC_FAC); LAS float* BSEG = (LAS float*)(lds + SC_BSEG2);
    unsigned rk[8];
    int unit = bx;
    if (unit < NUNIT) { const int bh = unit >> 6, c = unit & 63; const u16* kp_ = KA + ((size_t)(bh >> 2) * SEQ + c * 64 + 8 * w) * 512 + (bh & 3) * 128 + 2 * kp;
#pragma unroll
        for (int i = 0; i < 8; ++i) rk[i] = *(const unsigned*)(kp_ + i * 512); }
    for (; unit < NUNIT; unit += G) {
        const int bh = unit >> 6, c = unit & 63, b = bh >> 2, h = bh & 3, T0 = c * 64;
        const u16* vtp = VAT + ((size_t)(b * 512 + h * 128 + w * 16 + l15)) * SEQ + T0 + 8 * g;
        const s8v vt0 = *(const s8v*)vtp, vt1 = *(const s8v*)(vtp + 32);
        float k0[8], k1[8], cum0[8], cum1[8]; float c0 = 0.f, c1 = 0.f;
#pragma unroll
        for (int i = 0; i < 8; ++i) { k0[i] = h2f((u16)(rk[i] & 0xffffu)); k1[i] = h2f((u16)(rk[i] >> 16)); }
#pragma unroll
        for (int i = 0; i < 8; ++i) { c0 += lg2(1.f - k0[i]); c1 += lg2(1.f - k1[i]); cum0[i] = c0; cum1[i] = c1; }
        *(LAS f32x2*)(BSEG + w * 128 + 2 * kp) = (f32x2){c0, c1};
        { const int nu = unit + G; if (nu < NUNIT) { const int nbh = nu >> 6, nc = nu & 63; const u16* kp_ = KA + ((size_t)(nbh >> 2) * SEQ + nc * 64 + 8 * w) * 512 + (nbh & 3) * 128 + 2 * kp;
#pragma unroll
            for (int i = 0; i < 8; ++i) rk[i] = *(const unsigned*)(kp_ + i * 512); } }
        __syncthreads();
        {
            float pre0 = 0.f, pre1 = 0.f, bm0 = 0.f, bm1 = 0.f, bl0 = 0.f, bl1 = 0.f;
#pragma unroll
            for (int s = 0; s < 8; ++s) { const f32x2 v = *(const LAS f32x2*)(BSEG + s * 128 + 2 * kp);
                if (s < w) { pre0 += v[0]; pre1 += v[1]; } if (s < 4) { bm0 += v[0]; bm1 += v[1]; } bl0 += v[0]; bl1 += v[1]; }
            if (w == 0) { *(f32x2*)(EBL + (size_t)unit * 128 + 2 * kp) = (f32x2){ex2(bl0), ex2(bl1)}; *(LAS f32x2*)(FAC + 256 + 2 * kp) = (f32x2){ex2(bl0 - bm0), ex2(bl1 - bm1)}; }
            float a0[8], a1[8];
#pragma unroll
            for (int i = 0; i < 8; ++i) { a0[i] = k0[i] * ex2(fminf(bm0 - (pre0 + cum0[i]), 126.f)); a1[i] = k1[i] * ex2(fminf(bm1 - (pre1 + cum1[i]), 126.f)); }
            u32x4 p0, p1;
            p0.x = pkbf(a0[0], a0[1]); p0.y = pkbf(a0[2], a0[3]); p0.z = pkbf(a0[4], a0[5]); p0.w = pkbf(a0[6], a0[7]);
            p1.x = pkbf(a1[0], a1[1]); p1.y = pkbf(a1[2], a1[3]); p1.z = pkbf(a1[4], a1[5]); p1.w = pkbf(a1[6], a1[7]);
            *(LAS u32x4*)(lds + SC_KTT + (2 * kp) * SC_TP + 16 * w) = p0;
            *(LAS u32x4*)(lds + SC_KTT + (2 * kp + 1) * SC_TP + 16 * w) = p1;
        }
        __syncthreads();
        unsigned long long* up = UBUF + (((size_t)unit * 8 + w) * 8) * 64 + lane;
#pragma unroll
        for (int kb = 0; kb < 8; ++kb) {
            f32x4 ua = (f32x4){0.f, 0.f, 0.f, 0.f};
            ua = MFMA16B(*(const LAS s8v*)(lds + SC_KTT + (16 * kb + l15) * SC_TP + (8 * g) * 2), vt0, ua);
            ua = MFMA16B(*(const LAS s8v*)(lds + SC_KTT + (16 * kb + l15) * SC_TP + (32 + 8 * g) * 2), vt1, ua);
            const f32x4 e2 = *(const LAS f32x4*)(FAC + 256 + 16 * kb + 4 * g);
            ua = ua * e2;
            up[kb * 64] = (unsigned long long)pkbf(ua[0], ua[1]) | ((unsigned long long)pkbf(ua[2], ua[3]) << 32);
        }
    }
}

struct HalfSync { volatile LAS unsigned* cnt; unsigned target; };
template <bool DRAIN_VM = true> __device__ __forceinline__ void half_sync(HalfSync& hs) {
    if (DRAIN_VM) asm volatile("s_waitcnt vmcnt(0) lgkmcnt(0)" ::: "memory");
    else asm volatile("s_waitcnt lgkmcnt(0)" ::: "memory");
    hs.target += 4u;
    if ((threadIdx.x & 63) == 0) __hip_atomic_fetch_add((LAS unsigned*)hs.cnt, 1u, __ATOMIC_RELAXED, __HIP_MEMORY_SCOPE_WORKGROUP);
    unsigned spins = 0;
    while ((int)(*hs.cnt - hs.target) < 0) { __builtin_amdgcn_s_sleep(1); if (++spins > (1u << 24)) break; }
    asm volatile("" ::: "memory");
}
constexpr int SA4_KTT = 0, SA4_FAC = 18432, SA4_BSEG = 18944, SA4_ZS = 20992;
__device__ __forceinline__ void scanA4_all(int bx, int G, LAS unsigned char* zl0, HalfSync& hs, const u16* KA, const u16* VAT, unsigned long long* UBUF, float* EBL) {
    int tid_ = threadIdx.x; asm volatile("" : "+v"(tid_));
    const int lane = tid_ & 63, w4 = __builtin_amdgcn_readfirstlane((tid_ >> 6) - 4), l15 = lane & 15, g = lane >> 4, kp = lane;
    unsigned rk[2][16];
#define SA4_RAW(U, Z) do { const int bh_ = (U) >> 6, c_ = (U) & 63; const u16* kp_ = KA + ((size_t)(bh_ >> 2) * SEQ + c_ * 64 + 16 * w4) * 512 + (bh_ & 3) * 128 + 2 * kp; \
        _Pragma("unroll") for (int i = 0; i < 16; ++i) rk[Z][i] = *(const unsigned*)(kp_ + i * 512); } while (0)
    int ub = bx;
    if (ub < NUNIT) { SA4_RAW(ub, 0); const int u1 = (ub + G < NUNIT) ? ub + G : ub; SA4_RAW(u1, 1); }
    for (; ub < NUNIT; ub += 2 * G) {
        int un[2]; un[0] = ub; un[1] = (ub + G < NUNIT) ? ub + G : ub;
        s8v vt[2][2][2]; float cum0[2][16], cum1[2][16];
#pragma unroll
        for (int z = 0; z < 2; ++z) {
            const int unit = un[z], bh = unit >> 6, c = unit & 63, b = bh >> 2, h = bh & 3, T0 = c * 64;
            LAS float* BSEG = (LAS float*)(zl0 + z * SA4_ZS + SA4_BSEG);
#pragma unroll
            for (int y = 0; y < 2; ++y) { const u16* vtp = VAT + ((size_t)(b * 512 + h * 128 + (2 * w4 + y) * 16 + l15)) * SEQ + T0 + 8 * g; vt[z][y][0] = *(const s8v*)vtp; vt[z][y][1] = *(const s8v*)(vtp + 32); }
            float c0 = 0.f, c1 = 0.f;
#pragma unroll
            for (int i = 0; i < 16; ++i) { c0 += lg2(1.f - h2f((u16)(rk[z][i] & 0xffffu))); c1 += lg2(1.f - h2f((u16)(rk[z][i] >> 16))); cum0[z][i] = c0; cum1[z][i] = c1; }
            *(LAS f32x2*)(BSEG + w4 * 128 + 2 * kp) = (f32x2){c0, c1};
        }
        half_sync<false>(hs);
#pragma unroll
        for (int z = 0; z < 2; ++z) {
            const int unit = un[z];
            LAS unsigned char* zl = zl0 + z * SA4_ZS; LAS float* FAC = (LAS float*)(zl + SA4_FAC); LAS float* BSEG = (LAS float*)(zl + SA4_BSEG);
            float pre0 = 0.f, pre1 = 0.f, bm0 = 0.f, bm1 = 0.f, bl0 = 0.f, bl1 = 0.f;
#pragma unroll
            for (int s = 0; s < 4; ++s) { const f32x2 v = *(const LAS f32x2*)(BSEG + s * 128 + 2 * kp);
                if (s < w4) { pre0 += v[0]; pre1 += v[1]; } if (s < 2) { bm0 += v[0]; bm1 += v[1]; } bl0 += v[0]; bl1 += v[1]; }
            if (w4 == 0) { *(f32x2*)(EBL + (size_t)unit * 128 + 2 * kp) = (f32x2){ex2(bl0), ex2(bl1)}; *(LAS f32x2*)(FAC + 2 * kp) = (f32x2){ex2(bl0 - bm0), ex2(bl1 - bm1)}; }
#pragma unroll
            for (int hh = 0; hh < 2; ++hh) {
                float a0[8], a1[8];
#pragma unroll
                for (int i = 0; i < 8; ++i) { const unsigned r_ = rk[z][8 * hh + i];
                    a0[i] = h2f((u16)(r_ & 0xffffu)) * ex2(fminf(bm0 - (pre0 + cum0[z][8 * hh + i]), 126.f)); a1[i] = h2f((u16)(r_ >> 16)) * ex2(fminf(bm1 - (pre1 + cum1[z][8 * hh + i]), 126.f)); }
                u32x4 p0, p1;
                p0.x = pkbf(a0[0], a0[1]); p0.y = pkbf(a0[2], a0[3]); p0.z = pkbf(a0[4], a0[5]); p0.w = pkbf(a0[6], a0[7]);
                p1.x = pkbf(a1[0], a1[1]); p1.y = pkbf(a1[2], a1[3]); p1.z = pkbf(a1[4], a1[5]); p1.w = pkbf(a1[6], a1[7]);
                *(LAS u32x4*)(zl + SA4_KTT + (2 * kp) * SC_TP + 32 * w4 + 16 * hh) = p0;
                *(LAS u32x4*)(zl + SA4_KTT + (2 * kp + 1) * SC_TP + 32 * w4 + 16 * hh) = p1;
            }
        }
        { const int nb = ub + 2 * G; if (nb < NUNIT) { SA4_RAW(nb, 0); const int n1 = (nb + G < NUNIT) ? nb + G : nb; SA4_RAW(n1, 1); } }
        half_sync<false>(hs);
#pragma unroll
        for (int z = 0; z < 2; ++z) {
            const int unit = un[z];
            LAS unsigned char* zl = zl0 + z * SA4_ZS; LAS float* FAC = (LAS float*)(zl + SA4_FAC);
#pragma unroll
            for (int y = 0; y < 2; ++y) {
                unsigned long long* up = UBUF + (((size_t)unit * 8 + (2 * w4 + y)) * 8) * 64 + lane;
#pragma unroll
                for (int kb = 0; kb < 8; ++kb) {
                    f32x4 ua = (f32x4){0.f, 0.f, 0.f, 0.f};
                    ua = MFMA16B(*(const LAS s8v*)(zl + SA4_KTT + (16 * kb + l15) * SC_TP + (8 * g) * 2), vt[z][y][0], ua);
                    ua = MFMA16B(*(const LAS s8v*)(zl + SA4_KTT + (16 * kb + l15) * SC_TP + (32 + 8 * g) * 2), vt[z][y][1], ua);
                    const f32x4 e2 = *(const LAS f32x4*)(FAC + 16 * kb + 4 * g);
                    ua = ua * e2;
                    up[kb * 64] = (unsigned long long)pkbf(ua[0], ua[1]) | ((unsigned long long)pkbf(ua[2], ua[3]) << 32);
                }
            }
        }
    }
#undef SA4_RAW
}

__device__ __forceinline__ void scanB_all(int bx, int G, unsigned long long* UBUF, const float* EBL) {
    int tid_ = threadIdx.x; asm volatile("" : "+v"(tid_));
    constexpr int NSLOT = BATCH * 4 * 8 * 8 * 64;
    for (int s0 = bx * 256 + (tid_ & 255); s0 < NSLOT; s0 += 2 * G * 256) {
        const bool two = (s0 + G * 256 < NSLOT);
        const int sl[2] = {s0, two ? s0 + G * 256 : s0};
        unsigned long long* up[2]; const float* ep[2]; f32x4 S[2];
#pragma unroll
        for (int z = 0; z < 2; ++z) {
            const int slot = sl[z], ln = slot & 63, kb = (slot >> 6) & 7, w = (slot >> 9) & 7, bh = slot >> 12, g = ln >> 4;
            up[z] = UBUF + ((((size_t)bh * 64) * 8 + w) * 8 + kb) * 64 + ln;
            ep[z] = EBL + ((size_t)bh * 64) * 128 + 16 * kb + 4 * g;
            S[z] = (f32x4){0.f, 0.f, 0.f, 0.f};
        }
        for (int c0 = 0; c0 < 64; c0 += 8) {
            unsigned long long uv[2][8]; f32x4 ev[2][8];
#pragma unroll
            for (int z = 0; z < 2; ++z)
#pragma unroll
                for (int j = 0; j < 8; ++j) { uv[z][j] = up[z][(size_t)(c0 + j) * 4096]; ev[z][j] = *(const f32x4*)(ep[z] + (size_t)(c0 + j) * 128); }
#pragma unroll
            for (int z = 0; z < 2; ++z)
#pragma unroll
                for (int j = 0; j < 8; ++j) {
                    const unsigned lo = (unsigned)uv[z][j], hi = (unsigned)(uv[z][j] >> 32);
                    const f32x4 u4 = (f32x4){__uint_as_float(lo << 16), __uint_as_float(lo & 0xffff0000u), __uint_as_float(hi << 16), __uint_as_float(hi & 0xffff0000u)};
                    S[z] = ev[z][j] * S[z] + u4;
                    if (z == 0 || two) up[z][(size_t)(c0 + j) * 4096] = (unsigned long long)pkbf(S[z][0], S[z][1]) | ((unsigned long long)pkbf(S[z][2], S[z][3]) << 32);
                }
        }
    }
}

__device__ __forceinline__ void scanC_all(int bx, int G, LAS unsigned char* lds, const u16* QA, const u16* KA, const u16* VAT, const u16* GA, const unsigned long long* UBUF, u16* Y) {
    int tid_ = threadIdx.x; asm volatile("" : "+v"(tid_));
    const int tid = tid_, lane = tid & 63, w = __builtin_amdgcn_readfirstlane(tid >> 6), l15 = lane & 15, g = lane >> 4, kp = lane;
    LAS float* FAC = (LAS float*)(lds + SC_FAC); LAS float* BSEG = (LAS float*)(lds + SC_BSEG2); LAS float* SSQP = (LAS float*)(lds + SC_SSQ2);
    unsigned rk[8], rq[8];
    int unit = bx;
    if (unit < NUNIT) { const int bh = unit >> 6, c = unit & 63; const size_t o_ = ((size_t)(bh >> 2) * SEQ + c * 64 + 8 * w) * 512 + (bh & 3) * 128 + 2 * kp;
#pragma unroll
        for (int i = 0; i < 8; ++i) { rk[i] = *(const unsigned*)(KA + o_ + i * 512); rq[i] = *(const unsigned*)(QA + o_ + i * 512); } }
    for (; unit < NUNIT; unit += G) {
        const int bh = unit >> 6, c = unit & 63, b = bh >> 2, h = bh & 3, T0 = c * 64;
        const size_t rb = (size_t)b * SEQ;
        const u16* vtp = VAT + ((size_t)(b * 512 + h * 128 + w * 16 + l15)) * SEQ + T0 + 8 * g;
        const s8v vt0 = *(const s8v*)vtp, vt1 = *(const s8v*)(vtp + 32);
        unsigned long long sraw[8];
        { const unsigned long long* sp = UBUF + (((size_t)(c > 0 ? unit - 1 : unit) * 8 + w) * 8) * 64 + lane;
#pragma unroll
          for (int kb = 0; kb < 8; ++kb) { const unsigned long long v = sp[kb * 64]; sraw[kb] = (c > 0) ? v : 0ull; } }
        u32x2 gt[4];
#pragma unroll
        for (int ti = 0; ti < 4; ++ti) gt[ti] = *(const u32x2*)(GA + (rb + T0 + 16 * ti + l15) * 512 + h * 128 + 16 * w + 4 * g);
        float k0[8], k1[8], q0[8], q1[8], cum0[8], cum1[8]; float c0 = 0.f, c1 = 0.f;
#pragma unroll
        for (int i = 0; i < 8; ++i) { k0[i] = h2f((u16)(rk[i] & 0xffffu)); k1[i] = h2f((u16)(rk[i] >> 16)); q0[i] = __uint_as_float(rq[i] << 16); q1[i] = __uint_as_float(rq[i] & 0xffff0000u); }
#pragma unroll
        for (int i = 0; i < 8; ++i) { c0 += lg2(1.f - k0[i]); c1 += lg2(1.f - k1[i]); cum0[i] = c0; cum1[i] = c1; }
        *(LAS f32x2*)(BSEG + w * 128 + 2 * kp) = (f32x2){c0, c1};
        { const int nu = unit + G; if (nu < NUNIT) { const int nbh = nu >> 6, nc = nu & 63; const size_t o_ = ((size_t)(nbh >> 2) * SEQ + nc * 64 + 8 * w) * 512 + (nbh & 3) * 128 + 2 * kp;
#pragma unroll
            for (int i = 0; i < 8; ++i) { rk[i] = *(const unsigned*)(KA + o_ + i * 512); rq[i] = *(const unsigned*)(QA + o_ + i * 512); } } }
        __syncthreads();
        {
            float pre0 = 0.f, pre1 = 0.f, bm0 = 0.f, bm1 = 0.f;
#pragma unroll
            for (int s = 0; s < 7; ++s) { const f32x2 v = *(const LAS f32x2*)(BSEG + s * 128 + 2 * kp);
                if (s < w) { pre0 += v[0]; pre1 += v[1]; } if (s < 4) { bm0 += v[0]; bm1 += v[1]; } }
            if (w == 0) *(LAS f32x2*)(FAC + 2 * kp) = (f32x2){ex2(bm0), ex2(bm1)};
#pragma unroll
            for (int i = 0; i < 8; ++i) {
                const float d0 = pre0 + cum0[i] - bm0, d1 = pre1 + cum1[i] - bm1; const int t = 8 * w + i;
                *(LAS unsigned*)(lds + SC_QT + t * SC_QP + kp * 4) = pkbf(q0[i] * ex2(fminf(d0, 126.f)), q1[i] * ex2(fminf(d1, 126.f)));
                *(LAS unsigned*)(lds + SC_KT + t * SC_QP + kp * 4) = pkbf(k0[i] * ex2(fminf(-d0, 126.f)), k1[i] * ex2(fminf(-d1, 126.f)));
            }
        }
        __syncthreads();
        for (int id = w; id < 16; id += 8) {
            const int ti = id >> 2, sj = id & 3;
            f32x4 p = (f32x4){0.f, 0.f, 0.f, 0.f};
            if (sj <= ti) {
#pragma unroll
                for (int c4 = 0; c4 < 4; ++c4) {
                    const s8v a = *(const LAS s8v*)(lds + SC_KT + (16 * sj + l15) * SC_QP + (32 * c4 + 8 * g) * 2);
                    const s8v bb = *(const LAS s8v*)(lds + SC_QT + (16 * ti + l15) * SC_QP + (32 * c4 + 8 * g) * 2);
                    p = MFMA16B(a, bb, p);
                }
            }
            const int t = 16 * ti + l15, s0 = 16 * sj + 4 * g;
            u32x2 pw; pw.x = pkbf(s0 <= t ? p[0] : 0.f, s0 + 1 <= t ? p[1] : 0.f); pw.y = pkbf(s0 + 2 <= t ? p[2] : 0.f, s0 + 3 <= t ? p[3] : 0.f);
            *(LAS u32x2*)(lds + SC_PP + t * SC_TP + s0 * 2) = pw;
        }
        s8v sbf[4];
#pragma unroll
        for (int c4 = 0; c4 < 4; ++c4) {
            const f32x4 e0 = *(const LAS f32x4*)(FAC + 32 * c4 + 4 * g), e1 = *(const LAS f32x4*)(FAC + 32 * c4 + 16 + 4 * g);
            const unsigned a0 = (unsigned)sraw[2 * c4], a1 = (unsigned)(sraw[2 * c4] >> 32), b0 = (unsigned)sraw[2 * c4 + 1], b1 = (unsigned)(sraw[2 * c4 + 1] >> 32);
            u32x4 pk;
            pk.x = pkbf(__uint_as_float(a0 << 16) * e0[0], __uint_as_float(a0 & 0xffff0000u) * e0[1]); pk.y = pkbf(__uint_as_float(a1 << 16) * e0[2], __uint_as_float(a1 & 0xffff0000u) * e0[3]);
            pk.z = pkbf(__uint_as_float(b0 << 16) * e1[0], __uint_as_float(b0 & 0xffff0000u) * e1[1]); pk.w = pkbf(__uint_as_float(b1 << 16) * e1[2], __uint_as_float(b1 & 0xffff0000u) * e1[3]);
            sbf[c4] = __builtin_bit_cast(s8v, pk);
        }
        __syncthreads();
        f32x4 o[4];
#pragma unroll
        for (int ti = 0; ti < 4; ++ti) {
            f32x4 oo = (f32x4){0.f, 0.f, 0.f, 0.f};
            oo = MFMA16B(vt0, *(const LAS s8v*)(lds + SC_PP + (16 * ti + l15) * SC_TP + (8 * g) * 2), oo);
            oo = MFMA16B(vt1, *(const LAS s8v*)(lds + SC_PP + (16 * ti + l15) * SC_TP + (32 + 8 * g) * 2), oo);
#pragma unroll
            for (int c4 = 0; c4 < 4; ++c4) {
                const s4v lo = *(const LAS s4v*)(lds + SC_QT + (16 * ti + l15) * SC_QP + (32 * c4 + 4 * g) * 2);
                const s4v hh = *(const LAS s4v*)(lds + SC_QT + (16 * ti + l15) * SC_QP + (32 * c4 + 16 + 4 * g) * 2);
                oo = MFMA16B(sbf[c4], __builtin_shufflevector(lo, hh, 0, 1, 2, 3, 4, 5, 6, 7), oo);
            }
            o[ti] = oo;
        }
#pragma unroll
        for (int ti = 0; ti < 4; ++ti) {
            float s = (o[ti][0] * o[ti][0] + o[ti][1] * o[ti][1]) + (o[ti][2] * o[ti][2] + o[ti][3] * o[ti][3]);
            s += __shfl_xor(s, 16); s += __shfl_xor(s, 32);
            if (g == 0) SSQP[(16 * ti + l15) * 8 + w] = s;
        }
        __syncthreads();
#pragma unroll
        for (int ti = 0; ti < 4; ++ti) {
            const int t = 16 * ti + l15;
            const f32x4 s0 = *(const LAS f32x4*)(SSQP + t * 8), s1 = *(const LAS f32x4*)(SSQP + t * 8 + 4);
            const float rs = rstd_of((s0[0] + s0[1]) + (s0[2] + s0[3]) + (s1[0] + s1[1]) + (s1[2] + s1[3]), 128.f);
            const float g0 = __uint_as_float(gt[ti].x << 16), g1 = __uint_as_float(gt[ti].x & 0xffff0000u), g2 = __uint_as_float(gt[ti].y << 16), g3 = __uint_as_float(gt[ti].y & 0xffff0000u);
            u32x2 yo; yo.x = pkbf(o[ti][0] * rs * g0, o[ti][1] * rs * g1); yo.y = pkbf(o[ti][2] * rs * g2, o[ti][3] * rs * g3);
            *(u32x2*)(Y + (rb + T0 + t) * 1024 + h * 128 + 16 * w + 4 * g) = yo;
        }
    }
}

#define XB_TMO      128
#define XB_XCNT(j)  (256  + 64 * (j))
#define XB_XSUB(j)  (1280 + 64 * (j))
#define XB_XGEN(j)  (2304 + 64 * (j))
#define XB_TOP      3328
#define XB_TOPGEN   3392
#define XCD_BAR_WORDS 3456
#define XB_SPIN_CAP (1u << 18)

__device__ __forceinline__ unsigned xb_ld(unsigned* p)              { return __hip_atomic_load(p, __ATOMIC_RELAXED, __HIP_MEMORY_SCOPE_AGENT); }
__device__ __forceinline__ unsigned xb_add(unsigned* p, unsigned v) { return __hip_atomic_fetch_add(p, v, __ATOMIC_RELAXED, __HIP_MEMORY_SCOPE_AGENT); }
__device__ __forceinline__ unsigned xb_xcc_id() { return (unsigned)__builtin_amdgcn_s_getreg((3 << 11) | 20) & 0xFu; }
#define XB_SPIN(cond, bar) do { unsigned _sp = 0; while (cond) { __builtin_amdgcn_s_sleep(1); \
    if ((++_sp & 255u) == 0u) { if (xb_ld(&(bar)[XB_TMO])) break; if (_sp > XB_SPIN_CAP) { atomicAdd(&(bar)[XB_TMO], 1u); break; } } } } while (0)

struct XcdBarrier {
    unsigned* bar; unsigned x;
    volatile LAS unsigned* st;
};

__device__ __forceinline__ XcdBarrier xcd_barrier_post(unsigned* bar, volatile LAS unsigned* st) {
    XcdBarrier b; b.bar = bar; b.x = xb_xcc_id(); b.st = st;
    if (threadIdx.x == 0) (void)xb_add(&bar[XB_XCNT(b.x)], 1u);
    return b;
}
__device__ __forceinline__ void xcd_barrier_complete(unsigned* bar, unsigned x, unsigned& nloc, unsigned& nx) {
    const unsigned G = gridDim.x * gridDim.y * gridDim.z;
    unsigned sum, cnt, mine, sp = 0u;
    for (;;) {
        sum = 0u; cnt = 0u; mine = 0u;
#pragma unroll
        for (unsigned j = 0; j < 16; ++j) { const unsigned c = xb_ld(&bar[XB_XCNT(j)]); sum += c; cnt += (c > 0u) ? 1u : 0u; mine = (j == x) ? c : mine; }
        if (sum == G) break;
        __builtin_amdgcn_s_sleep(1);
        if ((++sp & 255u) == 0u) { if (xb_ld(&bar[XB_TMO])) break; if (sp > XB_SPIN_CAP) { atomicAdd(&bar[XB_TMO], 1u); break; } }
    }
    nloc = mine > 0u ? mine : 1u; nx = cnt > 0u ? cnt : 1u;
}

__device__ __forceinline__ void xcd_barrier(const XcdBarrier& b) {
    asm volatile("s_waitcnt vmcnt(0)" ::: "memory");
    __syncthreads();
    if (threadIdx.x == 0) {
        unsigned* bar = b.bar;
        __builtin_amdgcn_s_waitcnt(0);
        unsigned nloc = b.st[0], nx = b.st[1];
        if (nloc == 0u) { xcd_barrier_complete(bar, b.x, nloc, nx); b.st[0] = nloc; b.st[1] = nx; }
        const unsigned old = xb_add(&bar[XB_XSUB(b.x)], 1u);
        const unsigned gen = old / nloc;
        if (old + 1u == (gen + 1u) * nloc) {
            __builtin_amdgcn_fence(__ATOMIC_RELEASE, "agent");
            asm volatile("s_waitcnt vmcnt(0)" ::: "memory");
            const unsigned og = xb_add(&bar[XB_TOP], 1u);
            const unsigned tg = og / nx;
            if (og + 1u == (tg + 1u) * nx) xb_add(&bar[XB_TOPGEN], 1u);
            else XB_SPIN(xb_ld(&bar[XB_TOPGEN]) == tg, bar);
            __builtin_amdgcn_fence(__ATOMIC_ACQUIRE, "agent");
            xb_add(&bar[XB_XGEN(b.x)], 1u);
            asm volatile("s_waitcnt vmcnt(0)" ::: "memory");
        } else {
            XB_SPIN(xb_ld(&bar[XB_XGEN(b.x)]) == gen, bar);
            __builtin_amdgcn_fence(__ATOMIC_ACQUIRE, "agent");
            asm volatile("s_waitcnt vmcnt(0)" ::: "memory");
        }
    }
    __syncthreads();
}
__device__ __forceinline__ void xcd_barrier_upper(const XcdBarrier& b, HalfSync& hs) {
    half_sync(hs);
    if (threadIdx.x == 256) {
        unsigned* bar = b.bar;
        __builtin_amdgcn_s_waitcnt(0);
        unsigned nloc = b.st[0], nx = b.st[1];
        if (nloc == 0u) { xcd_barrier_complete(bar, b.x, nloc, nx); b.st[0] = nloc; b.st[1] = nx; }
        const unsigned old = xb_add(&bar[XB_XSUB(b.x)], 1u);
        const unsigned gen = old / nloc;
        if (old + 1u == (gen + 1u) * nloc) {
            __builtin_amdgcn_fence(__ATOMIC_RELEASE, "agent");
            asm volatile("s_waitcnt vmcnt(0)" ::: "memory");
            const unsigned og = xb_add(&bar[XB_TOP], 1u);
            const unsigned tg = og / nx;
            if (og + 1u == (tg + 1u) * nx) xb_add(&bar[XB_TOPGEN], 1u);
            else XB_SPIN(xb_ld(&bar[XB_TOPGEN]) == tg, bar);
            __builtin_amdgcn_fence(__ATOMIC_ACQUIRE, "agent");
            xb_add(&bar[XB_XGEN(b.x)], 1u);
            asm volatile("s_waitcnt vmcnt(0)" ::: "memory");
        } else {
            XB_SPIN(xb_ld(&bar[XB_XGEN(b.x)]) == gen, bar);
            __builtin_amdgcn_fence(__ATOMIC_ACQUIRE, "agent");
            asm volatile("s_waitcnt vmcnt(0)" ::: "memory");
        }
    }
    half_sync(hs);
}

#ifndef MK_MULTI
#define MK_MULTI 0
#endif
struct Args { const float* in[13]; float* out; unsigned char* ws; int ph_lo, ph_hi; };

__global__ void __launch_bounds__(512, 2) fwd_kernel(Args a) {
    extern __shared__ __attribute__((aligned(16))) unsigned char lds_raw[];
    LAS unsigned char* lds = (LAS unsigned char*)lds_raw;
    cg::grid_group grid = cg::this_grid();
    const int wave = __builtin_amdgcn_readfirstlane((int)threadIdx.x >> 6);
    const int G = gridDim.x, bx = blockIdx.x;
    const int gw = bx * 8 + wave, NGW = G * 8;
    unsigned char* ws = a.ws;
    unsigned* ctl = (unsigned*)(ws + WS_CTL);
    float* ssq = (float*)(ws + WS_CTL + CTL_SSQ);
    u16* WIN = (u16*)(ws + WS_WIN); u16* WOUT = (u16*)(ws + WS_WOUT); u16* WG = (u16*)(ws + WS_WG); u16* WP = (u16*)(ws + WS_WP);
    float* lbv = (float*)(ws + WS_SMALL);
    u16* PB = (u16*)(ws + WS_PB); u16* X0 = (u16*)(ws + WS_X0); u16* X1 = (u16*)(ws + WS_X1); u16* PROJ = (u16*)(ws + WS_PROJ); u16* PE = (u16*)(ws + WS_PE);
    const int lo = a.ph_lo, hi = a.ph_hi;
    volatile LAS unsigned* bst = (volatile LAS unsigned*)(lds + 147456 + 64);
    if (threadIdx.x < 8) bst[threadIdx.x] = 0u;
    __syncthreads();
    XcdBarrier xbar = xcd_barrier_post(ctl + 4096, bst);
    if (threadIdx.x == 256) (void)xb_add(&(ctl + 8192)[XB_XCNT(xbar.x)], 1u);
#define IN(k) (lo <= (k) && (k) < hi)
#define SEAM(k) do { if (IN(k) && IN((k) + 1)) { if (hi > 1000) grid.sync(); else xcd_barrier(xbar); } } while (0)

    if (IN(0)) {
        int tid_ = threadIdx.x; asm volatile("" : "+v"(tid_)); const int tid = tid_, lane = tid & 63;
        {
        LAS float* scr = (LAS float*)(lds + wave * 16384);
        constexpr int I_IN0 = (DM / 64) * (DIN / 32);
        for (int it = gw; it < I_IN0; it += NGW) p0_transpose_item(a.in[3], DM, DIN, WIN, a.in[2], nullptr, DM, scr, it, lane);
        for (int m0 = gw * 2; m0 < MTOK; m0 += NGW * 2) {
            f32x4 v[2][4];
#pragma unroll
            for (int r = 0; r < 2; ++r)
#pragma unroll
                for (int j = 0; j < 4; ++j) v[r][j] = *((const f32x4*)(a.in[0] + (size_t)(m0 + r) * DM) + lane + 64 * j);
#pragma unroll
            for (int r = 0; r < 2; ++r) {
                unsigned long long* o8 = (unsigned long long*)(X0 + (size_t)(m0 + r) * DM) + lane; float s = 0.f;
#pragma unroll
                for (int j = 0; j < 4; ++j) { const f32x4 x = v[r][j]; s += (x[0] * x[0] + x[1] * x[1]) + (x[2] * x[2] + x[3] * x[3]);
                    o8[64 * j] = (unsigned long long)pkbf(x[0], x[1]) | ((unsigned long long)pkbf(x[2], x[3]) << 32); }
                s = wave_sum(s);
                if (lane == 0) ssq[m0 + r] = s;
            }
        }
        if (bx == 0) { const float l0 = a.in[7][tid], l1 = a.in[7][512 + tid]; lbv[tid] = 1.f; lbv[512 + tid] = 1.f - 1.f / (1.f + __expf(l0 - l1)); }
        __syncthreads();
        }
    }
    SEAM(0);

    for (int l = 0; l < DEPTH; ++l) {
        const int pb = 1 + 5 * l;
        u16* XA = (l & 1) ? X1 : X0;
        u16* XB = (l & 1) ? X0 : X1;
        float* ssq_in = ssq + (size_t)(l == 0 ? 0 : 3 + 3 * (l - 1)) * MTOK;
        float* ssq_pe = ssq + (size_t)(1 + 3 * l) * MTOK; float* ssq_h1 = ssq + (size_t)(2 + 3 * l) * MTOK; float* ssq_h2 = ssq + (size_t)(3 + 3 * l) * MTOK;
        if (IN(pb)) {
            { pg8::Gemm g{XA, WIN + (size_t)l * DIN * DM, MTOK, DIN, DM}; pg8::StaticOrder S; S.init(MTOK, DIN, G, bx);
              EpiProj E{ssq_in, lbv + l * 512, PROJ};
              pg8::gemm_phase<EpiProj, pg8::StaticOrder, true, true>(lds, g, S, E);
            }
        }
        SEAM(pb);
        unsigned long long* UBUF = (unsigned long long*)a.out;
        float* EBL = (float*)(ws + WS_EBL);
        if (IN(pb + 1)) {
            if (wave < 4) {
                { int tl_ = threadIdx.x; asm volatile("" : "+v"(tl_));
                    const size_t NP = (size_t)MTOK * DPLE / 8, ST = (size_t)G * 256;
                    const f32x4* src = (const f32x4*)(a.in[1] + (size_t)l * MTOK * DPLE); u32x4* dst = (u32x4*)(PB + (size_t)l * MTOK * DPLE);
                    size_t i = (size_t)bx * 256 + tl_;
                    for (; i + 7 * ST < NP; i += 8 * ST) {
                        f32x4 v0[8], v1[8];
#pragma unroll
                        for (int j = 0; j < 8; ++j) { const size_t ii = i + j * ST; v0[j] = src[2 * ii]; v1[j] = src[2 * ii + 1]; }
#pragma unroll
                        for (int j = 0; j < 8; ++j) { const size_t ii = i + j * ST; u32x4 o; o.x = pkbf(v0[j][0], v0[j][1]); o.y = pkbf(v0[j][2], v0[j][3]); o.z = pkbf(v1[j][0], v1[j][1]); o.w = pkbf(v1[j][2], v1[j][3]); dst[ii] = o; }
                    }
                    for (; i < NP; i += ST) { const f32x4 v0 = src[2 * i], v1 = src[2 * i + 1]; u32x4 o; o.x = pkbf(v0[0], v0[1]); o.y = pkbf(v0[2], v0[3]); o.z = pkbf(v1[0], v1[1]); o.w = pkbf(v1[2], v1[3]); dst[i] = o; }
                }
                const int vcu = (G % 8 == 0) ? (bx % 8) * (G / 8) + bx / 8 : bx;
                    for (int u = vcu * 4 + wave; u < BATCH * 8 * (SEQ / 32); u += G * 4) {
                        attn_unit(u, lds + wave * 18432, PROJ + 4 * SEGSZ, PROJ + 5 * SEGSZ, PROJ + 6 * SEGSZ, PROJ + 7 * SEGSZ, XB);
                    }
            } else {
                volatile LAS unsigned* bst2 = (volatile LAS unsigned*)(lds + 147456 + 64);
                XcdBarrier ubar; ubar.bar = ctl + 8192; ubar.x = xb_xcc_id(); ubar.st = bst2 + 2;
                const int nu4 = (bx < NUNIT) ? ((NUNIT - bx + G - 1) / G + 1) / 2 : 0;
                HalfSync hs; hs.cnt = bst2 + 4; hs.target = (unsigned)(l * 4 * (2 * nu4 + 3));
                scanA4_all(bx, G, lds + 73728, hs, PROJ + 1 * SEGSZ, PROJ + 2 * SEGSZ, UBUF, EBL);
                xcd_barrier_upper(ubar, hs);
                scanB_all(bx, G, UBUF, EBL);
                half_sync<false>(hs);
                {
                    int tq_ = threadIdx.x; asm volatile("" : "+v"(tq_)); const int t4 = tq_ & 255, ln = tq_ & 63;
                    LAS float* scr = (LAS float*)(lds + 73728 + (wave - 4) * 16384);
                    const int gw4 = bx * 4 + (wave - 4), NGW4 = G * 4;
                    constexpr int I_IN = (DM / 64) * (DIN / 32), I_SQ = (DM / 64) * (DM / 32), I_P = (DPLE / 64) * (DM / 32);
                    const int nit = 2 * I_SQ + I_P + ((l + 1 < DEPTH) ? I_IN : 0);
                    for (int it = gw4; it < nit; it += NGW4) {
                        int r = it;
                        if (r < I_SQ) { p0_transpose_item(a.in[6] + (size_t)l * DM * DM, DM, DM, WOUT + (size_t)l * DM * DM, a.in[4] + l * 512, a.in[5] + l * 512, 512, scr, r, ln); continue; } r -= I_SQ;
                        if (r < I_SQ) { p0_transpose_item(a.in[9] + (size_t)l * DM * DM, DM, DM, WG + (size_t)l * DM * DM, a.in[8] + l * DM, nullptr, DM, scr, r, ln); continue; } r -= I_SQ;
                        if (r < I_P) { p0_transpose_item(a.in[10] + (size_t)l * DPLE * DM, DPLE, DM, WP + (size_t)l * DM * DPLE, nullptr, nullptr, 0, scr, r, ln); continue; } r -= I_P;
                        p0_transpose_item(a.in[3] + (size_t)(l + 1) * DM * DIN, DM, DIN, WIN + (size_t)(l + 1) * DIN * DM, a.in[2] + (l + 1) * DM, nullptr, DM, scr, r, ln);
                    }
                }
            }
            __syncthreads();
        }
        SEAM(pb + 1);
        if (IN(pb + 2)) {
            scanC_all(bx, G, lds, PROJ + 0 * SEGSZ, PROJ + 1 * SEGSZ, PROJ + 2 * SEGSZ, PROJ + 3 * SEGSZ, UBUF, XB);
            __syncthreads();
        }
        SEAM(pb + 2);
        if (IN(pb + 3)) {
            pg8::Gemm g{XB, WOUT + (size_t)l * DM * DM, MTOK, DM, DM}; pg8::StaticOrder S; S.init(MTOK, DM, G, bx);
            EpiH1 E{XA, ssq_h1};
            pg8::gemm_phase<EpiH1, pg8::StaticOrder, true, true>(lds, g, S, E);
            { int kple = DPLE; asm volatile("" : "+s"(kple));
              pg8::Gemm g{PB + (size_t)l * MTOK * DPLE, WP + (size_t)l * DM * DPLE, MTOK, DM, kple}; pg8::StaticOrder S; S.init(MTOK, DM, G, bx);
              EpiPe E{PE, ssq_pe};
              pg8::gemm_phase<EpiPe, pg8::StaticOrder, true, true>(lds, g, S, E);
            }
        }
        SEAM(pb + 3);
        if (IN(pb + 4)) {
            pg8::Gemm g{XA, WG + (size_t)l * DM * DM, MTOK, DM, DM}; pg8::StaticOrder S; S.init(MTOK, DM, G, bx);
            EpiGate E{ssq_h1, ssq_pe, a.in[11] + l * DM, PE, XA, XB, ssq_h2};
            pg8::gemm_phase<EpiGate, pg8::StaticOrder, true, true>(lds, g, S, E);
        }
        SEAM(pb + 4);
    }
    if (IN(NPHASE - 1)) {
        int tidf_ = threadIdx.x; asm volatile("" : "+v"(tidf_)); const int lane = tidf_ & 63;
        const float* sq = ssq + (size_t)(3 + 3 * (DEPTH - 1)) * MTOK;
        const u16* HL = ((DEPTH - 1) & 1) ? X0 : X1;
        for (int m0 = gw * 2; m0 < MTOK; m0 += NGW * 2) {
            u32x4 hv[2][2]; float sv[2];
#pragma unroll
            for (int r = 0; r < 2; ++r) { sv[r] = sq[m0 + r];
#pragma unroll
                for (int j = 0; j < 2; ++j) hv[r][j] = *(const u32x4*)(HL + (size_t)(m0 + r) * DM + 512 * j + 8 * lane); }
#pragma unroll
            for (int r = 0; r < 2; ++r) { const float rs = rstd_of(sv[r], 1024.f);
#pragma unroll
                for (int j = 0; j < 2; ++j) { f32x4 a0, a1; unpack8(hv[r][j], a0, a1);
                    const f32x4 g0 = *(const f32x4*)(a.in[12] + 512 * j + 8 * lane), g1 = *(const f32x4*)(a.in[12] + 512 * j + 8 * lane + 4);
                    float* op = a.out + (size_t)(m0 + r) * DM + 512 * j + 8 * lane;
                    *(f32x4*)op = a0 * rs * g0; *(f32x4*)(op + 4) = a1 * rs * g1; } }
        }
    }
#undef IN
#undef SEAM
}

extern "C" void kernel_launch(void* const* d_in, const int* in_sizes, int n_in, void* d_out, int out_size, void* d_ws, size_t ws_size, hipStream_t stream) {
    static int grid = 0;
    if (grid == 0) {
        if (n_in != 13 || in_sizes[0] != MTOK * DM || out_size != MTOK * DM || ws_size < WS_END) {
            fprintf(stderr, "kernel_launch: unexpected shapes (n_in %d, in0 %d, out %d, ws %zu); nothing launched\n", n_in, n_in > 0 ? in_sizes[0] : -1, out_size, ws_size); grid = -1; return; }
        int dev = 0, cus = 0, per_cu = 0;
        hipGetDevice(&dev);
        hipDeviceGetAttribute(&cus, hipDeviceAttributeMultiprocessorCount, dev);
        if (hipFuncSetAttribute((const void*)fwd_kernel, hipFuncAttributeMaxDynamicSharedMemorySize, LDS_BYTES) != hipSuccess) { fprintf(stderr, "kernel_launch: hipFuncSetAttribute failed\n"); grid = -1; return; }
        if (hipOccupancyMaxActiveBlocksPerMultiprocessor(&per_cu, (const void*)fwd_kernel, 512, LDS_BYTES) != hipSuccess || per_cu < 1) { fprintf(stderr, "kernel_launch: occupancy query gave %d\n", per_cu); per_cu = 1; }
        (void)hipGetLastError();
        grid = cus * per_cu;
        if (grid < 32) { fprintf(stderr, "kernel_launch: grid %d too small\n", grid); grid = -1; return; }
    }
    if (grid < 0) return;
    (void)hipMemsetAsync((char*)d_ws + WS_CTL, 0, CTL_BYTES, stream);
    Args a{};
    for (int i = 0; i < 13; ++i) a.in[i] = (const float*)d_in[i];
    a.out = (float*)d_out; a.ws = (unsigned char*)d_ws;
#if MK_MULTI
    for (int ph = 0; ph < NPHASE; ++ph) { a.ph_lo = ph; a.ph_hi = ph + 1; hipLaunchKernelGGL(fwd_kernel, dim3(grid), dim3(512), LDS_BYTES, stream, a); }
#else
    a.ph_lo = 0; a.ph_hi = NPHASE;
    void* args[] = {&a};
    hipError_t e = hipLaunchCooperativeKernel((const void*)fwd_kernel, dim3(grid), dim3(512), args, LDS_BYTES, stream);
    if (e != hipSuccess) fprintf(stderr, "kernel_launch: cooperative launch failed: %s (grid %d)\n", hipGetErrorString(e), grid);
#endif
}
```

```cpp
#include <hip/hip_runtime.h>
#include <hip/hip_cooperative_groups.h>
#include <cstdio>
#include <cstdint>
namespace cg = cooperative_groups;
#define MK_MULTI 0
namespace pg8 {
#define PG8_LAS __attribute__((address_space(3)))
typedef unsigned short bf16_t;
typedef short bf16x8 __attribute__((ext_vector_type(8)));
typedef float f32x4 __attribute__((ext_vector_type(4)));
typedef unsigned u32x4 __attribute__((ext_vector_type(4)));
constexpr int BM = 256, BK = 64, HALF = 128, HTB = HALF * BK * 2  , STAGE_BYTES = 8 * HTB, NXCD = 8, WGM = 8;

__host__ __device__ __forceinline__ int lds_byte(int r, int c) { const int st = (r >> 4) * 2 + (c >> 5), rr = r & 15, cc = c & 31, ob = rr * 64 + cc * 2; return st * 1024 + (ob ^ (((ob >> 9) & 1) << 5)); }
__host__ __device__ __forceinline__ void stage_rc(int b, int& R, int& C) { const int st = b / 1024, sb = b % 1024, swz = sb ^ (((sb >> 9) & 1) << 5); R = (st >> 1) * 16 + swz / 64; C = (st & 1) * 32 + (swz % 64) / 2; }
__host__ __device__ __forceinline__ int perm32(int rho) { const int n = rho >> 4, i = rho & 15; return 8 * (i >> 2) + 4 * n + (i & 3); }

struct Unit { int pm, pn; };
struct Gemm { const bf16_t* A; const bf16_t* Bt; int M, N, K; };

struct StaticOrder {
    int nM, nN, nwg, G, c;
    __host__ __device__ void init(int M, int N, int G_, int c_) { nM = M / BM; nN = N / BM; nwg = nM * nN; G = G_; c = c_; }
    __host__ __device__ bool next(int i, Unit& u) const {
        const long L = (long)i * G + c; if (L >= nwg) return false;
        int wgid = (int)L; { const int q = nwg / NXCD, r = nwg % NXCD, xcd = wgid % NXCD, off = wgid / NXCD; wgid = (xcd < r ? xcd * (q + 1) : r * (q + 1) + (xcd - r) * q) + off; }
        const int nig = WGM * nN, gid = wgid / nig, fm = gid * WGM, gsz = (nM - fm) < WGM ? (nM - fm) : WGM;
        u.pm = fm + ((wgid % nig) % gsz); u.pn = (wgid % nig) / gsz; return true;
    }
    __device__ __forceinline__ void a_ready(const Unit&) const {}
    __device__ __forceinline__ void done(const Unit&) const {}
};

__device__ __forceinline__ unsigned cvt_pk_bf16(float lo, float hi) { unsigned r; asm volatile("v_cvt_pk_bf16_f32 %0, %1, %2" : "=v"(r) : "v"(lo), "v"(hi)); return r; }
typedef float f32x2 __attribute__((ext_vector_type(2)));
template <class Epi, class Sched, bool ALIGN_EPI = false, bool SP2 = false>
__device__ __forceinline__ void gemm_phase(PG8_LAS unsigned char* lds, const Gemm g, const Sched& S, const Epi& E) {
    int tid_ = threadIdx.x; asm volatile("" : "+v"(tid_));
    const int tid = tid_, wid = __builtin_amdgcn_readfirstlane(tid >> 6), lane = tid & 63, wr = wid >> 2, wc = wid & 3, fr = lane & 15, fq = lane >> 4;
    const int K = g.K, nt = K / BK;
    unsigned voffA[2], voffB[2];
#pragma unroll
    for (int i = 0; i < 2; ++i) { int R, C; stage_rc(tid * 16 + i * 8192, R, C); const int Rb = Epi::PERM ? ((R & ~31) + perm32(R & 31)) : R;
        voffA[i] = (unsigned)(R * K + C) * 2u; voffB[i] = (unsigned)(Rb * K + C) * 2u; }
    const size_t kstep = (size_t)(BK * 2);
    const size_t hstep = (size_t)HALF * K * 2;
    const size_t tstep = 2 * hstep;
    const unsigned ldsw = (unsigned)wid * 1024u;
    const int aoff = lds_byte(wr * 64 + fr, fq * 8), boff = lds_byte(wc * 32 + fr, fq * 8);
#define PG8_SA(b, h) (((b) * 2 + (h)) * HTB)
#define PG8_SB(b, h) ((4 + (b) * 2 + (h)) * HTB)
#define PG8_STAGE(bufoff, gbase, voff) do { _Pragma("unroll") for (int _i = 0; _i < 2; ++_i) \
        __builtin_amdgcn_global_load_lds((const unsigned*)((const char*)(gbase) + (voff)[_i]), (PG8_LAS unsigned*)(lds + (bufoff) + ldsw + _i * 8192), 16, 0, 0); } while (0)
#define PG8_LDA(dst, b, h) do { _Pragma("unroll") for (int m = 0; m < 4; ++m) _Pragma("unroll") for (int k = 0; k < 2; ++k) dst[m][k] = *(const PG8_LAS bf16x8*)(lds + PG8_SA(b, h) + aoff + m * 2048 + k * 1024); } while (0)
#define PG8_LDB(dst, b, h) do { _Pragma("unroll") for (int n = 0; n < 2; ++n) _Pragma("unroll") for (int k = 0; k < 2; ++k) dst[n][k] = *(const PG8_LAS bf16x8*)(lds + PG8_SB(b, h) + boff + n * 2048 + k * 1024); } while (0)
#define PG8_MMA(ai, bj, At, Bt) do { __builtin_amdgcn_s_setprio(1); _Pragma("unroll") for (int m = 0; m < 4; ++m) _Pragma("unroll") for (int n = 0; n < 2; ++n) _Pragma("unroll") for (int k = 0; k < 2; ++k) \
        acc[ai][bj][m][n] = __builtin_amdgcn_mfma_f32_16x16x32_bf16(Bt[n][k], At[m][k], acc[ai][bj][m][n], 0, 0, 0); __builtin_amdgcn_s_setprio(0); } while (0)
#define PG8_WAIT_V(n) asm volatile("s_waitcnt vmcnt(" #n ")" ::: "memory")
#define PG8_WAIT_L(n) asm volatile("s_waitcnt lgkmcnt(" #n ")" ::: "memory")
#define PG8_BAR __builtin_amdgcn_s_barrier()
#define PG8_SCHED __builtin_amdgcn_sched_barrier(0)
    Unit cur, nxt; int ui = 0;
    if (!S.next(0, cur)) return;
    f32x4 acc[2][2][4][2];
#pragma unroll
    for (int a = 0; a < 2; ++a)
#pragma unroll
        for (int b = 0; b < 2; ++b)
#pragma unroll
            for (int m = 0; m < 4; ++m)
#pragma unroll
                for (int n = 0; n < 2; ++n) acc[a][b][m][n] = (f32x4){0.f, 0.f, 0.f, 0.f};
    bf16x8 At[4][2], B0[2][2], B1[2][2];
    const char* cA = (const char*)g.A + (size_t)cur.pm * tstep; const char* cB = (const char*)g.Bt + (size_t)cur.pn * tstep;
    S.a_ready(cur);
    if constexpr (SP2) {
        PG8_STAGE(PG8_SB(0, 0), cB, voffB); PG8_STAGE(PG8_SB(0, 1), cB + hstep, voffB); PG8_STAGE(PG8_SA(0, 0), cA, voffA); PG8_STAGE(PG8_SA(0, 1), cA + hstep, voffA);
        if (wr == 1) PG8_BAR;
        PG8_WAIT_V(2); PG8_BAR;
        PG8_STAGE(PG8_SB(1, 0), cB + kstep, voffB); PG8_STAGE(PG8_SA(1, 0), cA + kstep, voffA); PG8_STAGE(PG8_SB(1, 1), cB + hstep + kstep, voffB);
        PG8_WAIT_V(6); PG8_BAR;
    } else {
        PG8_STAGE(PG8_SB(0, 0), cB, voffB); PG8_STAGE(PG8_SA(0, 0), cA, voffA); PG8_STAGE(PG8_SB(0, 1), cB + hstep, voffB); PG8_STAGE(PG8_SA(0, 1), cA + hstep, voffA);
        if (wr == 1) PG8_BAR;
        PG8_WAIT_V(4); PG8_BAR;
        PG8_STAGE(PG8_SB(1, 0), cB + kstep, voffB); PG8_STAGE(PG8_SA(1, 0), cA + kstep, voffA); PG8_STAGE(PG8_SB(1, 1), cB + hstep + kstep, voffB);
        PG8_WAIT_V(6); PG8_BAR;
    }
    for (;;) {
        const bool has_next = S.next(ui + 1, nxt);
        const char* nA = has_next ? (const char*)g.A + (size_t)nxt.pm * tstep : cA; const char* nB = has_next ? (const char*)g.Bt + (size_t)nxt.pn * tstep : cB;
        for (int t = 0; t < nt; t += 2) {
            const bool last = (t == nt - 2);
            const char* a1 = cA + (size_t)(t + 1) * kstep;
            const char* a2 = last ? nA : cA + (size_t)(t + 2) * kstep; const char* b2 = last ? nB : cB + (size_t)(t + 2) * kstep;
            const char* a3 = a2 + kstep; const char* b3 = b2 + kstep;
            if (last && has_next) S.a_ready(nxt);
            if constexpr (SP2) {
            PG8_LDB(B0, 0, 0); PG8_LDB(B1, 0, 1); PG8_SCHED; PG8_LDA(At, 0, 0); PG8_STAGE(PG8_SA(1, 1), a1 + hstep, voffA);
            PG8_WAIT_V(8); PG8_WAIT_L(0); PG8_BAR; PG8_MMA(0, 0, At, B0); PG8_MMA(0, 1, At, B1); PG8_BAR; PG8_SCHED;
            PG8_LDA(At, 0, 1); PG8_STAGE(PG8_SB(0, 0), b2, voffB); PG8_STAGE(PG8_SB(0, 1), b2 + hstep, voffB); PG8_STAGE(PG8_SA(0, 0), a2, voffA);
            PG8_WAIT_V(8); PG8_WAIT_L(0); PG8_BAR; PG8_MMA(1, 0, At, B0); PG8_MMA(1, 1, At, B1); PG8_BAR; PG8_SCHED;
            PG8_LDB(B0, 1, 0); PG8_LDB(B1, 1, 1); PG8_SCHED; PG8_LDA(At, 1, 0); PG8_STAGE(PG8_SA(0, 1), a2 + hstep, voffA);
            PG8_WAIT_V(8); PG8_WAIT_L(0); PG8_BAR; PG8_MMA(0, 0, At, B0); PG8_MMA(0, 1, At, B1); PG8_BAR; PG8_SCHED;
            PG8_LDA(At, 1, 1); PG8_STAGE(PG8_SB(1, 0), b3, voffB); PG8_STAGE(PG8_SB(1, 1), b3 + hstep, voffB); PG8_STAGE(PG8_SA(1, 0), a3, voffA);
            PG8_WAIT_V(8); PG8_WAIT_L(0); PG8_BAR; PG8_MMA(1, 0, At, B0); PG8_MMA(1, 1, At, B1); PG8_BAR; PG8_SCHED;
            } else {
            PG8_LDB(B0, 0, 0); PG8_SCHED; PG8_LDA(At, 0, 0); PG8_STAGE(PG8_SA(1, 1), a1 + hstep, voffA);
            PG8_WAIT_L(8); PG8_BAR; PG8_WAIT_L(0); PG8_MMA(0, 0, At, B0); PG8_BAR; PG8_SCHED;
            PG8_LDB(B1, 0, 1); PG8_STAGE(PG8_SB(0, 0), b2, voffB);
            PG8_BAR; PG8_WAIT_L(0); PG8_MMA(0, 1, At, B1); PG8_BAR;
            PG8_LDA(At, 0, 1); PG8_STAGE(PG8_SA(0, 0), a2, voffA);
            PG8_BAR; PG8_WAIT_L(0); PG8_MMA(1, 0, At, B0); PG8_BAR; PG8_SCHED;
            PG8_STAGE(PG8_SB(0, 1), b2 + hstep, voffB);
            PG8_WAIT_V(6); PG8_BAR; PG8_MMA(1, 1, At, B1); PG8_BAR;
            PG8_LDB(B0, 1, 0); PG8_SCHED; PG8_LDA(At, 1, 0); PG8_STAGE(PG8_SA(0, 1), a2 + hstep, voffA);
            PG8_WAIT_L(8); PG8_BAR; PG8_WAIT_L(0); PG8_MMA(0, 0, At, B0); PG8_BAR; PG8_SCHED;
            PG8_LDB(B1, 1, 1); PG8_STAGE(PG8_SB(1, 0), b3, voffB);
            PG8_BAR; PG8_WAIT_L(0); PG8_MMA(0, 1, At, B1); PG8_BAR;
            PG8_LDA(At, 1, 1); PG8_STAGE(PG8_SA(1, 0), a3, voffA);
            PG8_BAR; PG8_WAIT_L(0); PG8_MMA(1, 0, At, B0); PG8_BAR; PG8_SCHED;
            PG8_STAGE(PG8_SB(1, 1), b3 + hstep, voffB);
            PG8_WAIT_V(6); PG8_BAR; PG8_MMA(1, 1, At, B1); PG8_BAR;
            }
        }
        if constexpr (ALIGN_EPI) { if (wr == 0) PG8_BAR; }
        if constexpr (!Epi::AFTER_DRAIN) { E(acc, cur, wr, wc, fr, fq); S.done(cur); }
        if (!has_next) break;
#pragma unroll
        for (int a = 0; a < 2; ++a)
#pragma unroll
            for (int b = 0; b < 2; ++b)
#pragma unroll
                for (int m = 0; m < 4; ++m)
#pragma unroll
                    for (int n = 0; n < 2; ++n) acc[a][b][m][n] = (f32x4){0.f, 0.f, 0.f, 0.f};
        cur = nxt; cA = nA; cB = nB; ++ui;
        if constexpr (ALIGN_EPI) { if (wr == 1) PG8_BAR; }
    }
    PG8_WAIT_V(0);
    if constexpr (!ALIGN_EPI) { if (wr == 0) PG8_BAR; }
    PG8_BAR;
    if constexpr (Epi::AFTER_DRAIN) { E.fused(acc, cur, wr, wc, fr, fq, lds, wid, lane); S.done(cur); }
#undef PG8_SA
#undef PG8_SB
#undef PG8_STAGE
#undef PG8_LDA
#undef PG8_LDB
#undef PG8_MMA
#undef PG8_WAIT_V
#undef PG8_WAIT_L
#undef PG8_BAR
#undef PG8_SCHED
}
}

constexpr int BATCH = 8, SEQ = 4096, DM = 1024, MTOK = BATCH * SEQ, DEPTH = 2, DIN = 4096, DPLE = 256;
constexpr float EPS = 1e-6f;
constexpr float LOG2E = 1.4426950408889634f;
constexpr float QSCALE = 0.125f * LOG2E;
#define LAS __attribute__((address_space(3)))
typedef unsigned short u16;
typedef short s8v __attribute__((ext_vector_type(8)));
typedef short s4v __attribute__((ext_vector_type(4)));
typedef _Float16 h8v __attribute__((ext_vector_type(8)));
typedef _Float16 h2v __attribute__((ext_vector_type(2)));
typedef float f32x2 __attribute__((ext_vector_type(2)));
typedef float f32x4 __attribute__((ext_vector_type(4)));
typedef float f32x16 __attribute__((ext_vector_type(16)));
typedef unsigned u32x4 __attribute__((ext_vector_type(4)));
typedef unsigned u32x2 __attribute__((ext_vector_type(2)));

constexpr size_t MiB = 1u << 20;
constexpr size_t WS_CTL = 0, CTL_BYTES = 1 * MiB;
constexpr size_t WS_WIN = 1 * MiB;
constexpr size_t WS_WOUT = 17 * MiB;
constexpr size_t WS_WG = 21 * MiB;
constexpr size_t WS_WP = 25 * MiB;
constexpr size_t WS_SMALL = 26 * MiB;
constexpr size_t WS_PB = 27 * MiB;
constexpr size_t WS_X0 = 59 * MiB, WS_X1 = 123 * MiB;
constexpr size_t WS_PROJ = 187 * MiB;
constexpr size_t WS_PE = 443 * MiB;
constexpr size_t WS_EBL = 507 * MiB;
constexpr size_t WS_END = 509 * MiB;
constexpr size_t CTL_SSQ = 65536;
constexpr size_t SEGSZ = (size_t)MTOK * 512;
constexpr int LDS_BYTES = 148480;
constexpr int NPHASE = 12;
#define ATT_THR -150.f

__device__ __forceinline__ float bf2f(u16 u) { return __uint_as_float((unsigned)u << 16); }
__device__ __forceinline__ float h2f(u16 u) { return (float)__builtin_bit_cast(_Float16, u); }
__device__ __forceinline__ unsigned pkbf(float lo, float hi) { unsigned r; asm volatile("v_cvt_pk_bf16_f32 %0, %1, %2" : "=v"(r) : "v"(lo), "v"(hi)); return r; }
__device__ __forceinline__ u16 f2bf(float f) { return (u16)(pkbf(f, 0.f) & 0xffffu); }
__device__ __forceinline__ unsigned pkh(float lo, float hi) { h2v v = {(_Float16)lo, (_Float16)hi}; return __builtin_bit_cast(unsigned, v); }
__device__ __forceinline__ float ex2(float x) { return __builtin_amdgcn_exp2f(x); }
__device__ __forceinline__ float lg2(float x) { return __builtin_amdgcn_logf(x); }
__device__ __forceinline__ float fmin120(float a) { float r; asm("v_min_f32 %0, 0x42f00000, %1" : "=v"(r) : "v"(a)); return r; }
__device__ __forceinline__ float sigmoid_f(float v) { return __builtin_amdgcn_rcpf(1.f + ex2(-v * LOG2E)); }
__device__ __forceinline__ float silu_f(float v) { return v * sigmoid_f(v); }
__device__ __forceinline__ float rstd_of(float ssq, float n) { return __builtin_amdgcn_rsqf(ssq * (1.f / n) + EPS); }

struct EpiProj {
    static constexpr bool PERM = true, AFTER_DRAIN = false;
    const float* ssq; const float* lbv; u16* proj;
    __device__ __forceinline__ void operator()(const pg8::f32x4 (&acc)[2][2][4][2], const pg8::Unit& u, int wr, int wc, int fr, int fq) const {
        const int seg = u.pn >> 1;
        u16* dst = proj + (size_t)seg * SEGSZ;
        const int cb = (u.pn & 1) * 256 + wc * 32 + 8 * fq;
        const bool isf16 = (seg == 1) | (seg == 4) | (seg == 5) | (seg == 6);
        const bool tr = (seg == 2) | (seg == 6);
        const bool dosilu = (seg == 0) | (seg == 3) | (seg == 7);
        float lb8[2][8];
#pragma unroll
        for (int bj = 0; bj < 2; ++bj)
#pragma unroll
            for (int j = 0; j < 8; ++j) lb8[bj][j] = (seg == 1) ? lbv[cb + bj * 128 + j] : 1.f;
        float rsv[2][4];
#pragma unroll
        for (int ai = 0; ai < 2; ++ai)
#pragma unroll
            for (int m = 0; m < 4; ++m) rsv[ai][m] = ssq[u.pm * 256 + ai * 128 + wr * 64 + m * 16 + fr];
#pragma unroll
        for (int ai = 0; ai < 2; ++ai)
#pragma unroll
            for (int m = 0; m < 4; ++m) {
                const int row = u.pm * 256 + ai * 128 + wr * 64 + m * 16 + fr;
                const float rs = rstd_of(rsv[ai][m], 1024.f);
#pragma unroll
                for (int bj = 0; bj < 2; ++bj) {
                    float v[8];
#pragma unroll
                    for (int n = 0; n < 2; ++n)
#pragma unroll
                        for (int j = 0; j < 4; ++j) v[4 * n + j] = acc[ai][bj][m][n][j] * rs;
                    if (dosilu) {
#pragma unroll
                        for (int j = 0; j < 8; ++j) v[j] = silu_f(v[j]);
                    } else if (seg == 1) {
#pragma unroll
                        for (int j = 0; j < 8; ++j) v[j] = fminf(lb8[bj][j] * sigmoid_f(-v[j]), 0.9995f);
                    } else if (seg == 4) {
#pragma unroll
                        for (int j = 0; j < 8; ++j) v[j] *= QSCALE;
                    }
                    u32x4 w;
                    if (isf16) { w.x = pkh(v[0], v[1]); w.y = pkh(v[2], v[3]); w.z = pkh(v[4], v[5]); w.w = pkh(v[6], v[7]); }
                    else { w.x = pkbf(v[0], v[1]); w.y = pkbf(v[2], v[3]); w.z = pkbf(v[4], v[5]); w.w = pkbf(v[6], v[7]); }
                    if (!tr) { *(u32x4*)(dst + (size_t)row * 512 + cb + bj * 128) = w; }
                    else {
                        u16* p = dst + ((size_t)((row >> 12) * 512 + cb + bj * 128)) * SEQ + (row & 4095);
                        p[0 * SEQ] = (u16)(w.x & 0xffffu); p[1 * SEQ] = (u16)(w.x >> 16); p[2 * SEQ] = (u16)(w.y & 0xffffu); p[3 * SEQ] = (u16)(w.y >> 16);
                        p[4 * SEQ] = (u16)(w.z & 0xffffu); p[5 * SEQ] = (u16)(w.z >> 16); p[6 * SEQ] = (u16)(w.w & 0xffffu); p[7 * SEQ] = (u16)(w.w >> 16);
                    }
                }
            }
    }
};
struct EpiPe {
    static constexpr bool PERM = true, AFTER_DRAIN = false;
    u16* pe; float* ssq;
    __device__ __forceinline__ void operator()(const pg8::f32x4 (&acc)[2][2][4][2], const pg8::Unit& u, int wr, int wc, int fr, int fq) const {
        const int cb = u.pn * 256 + wc * 32 + 8 * fq;
#pragma unroll
        for (int ai = 0; ai < 2; ++ai)
#pragma unroll
            for (int m = 0; m < 4; ++m) {
                const int row = u.pm * 256 + ai * 128 + wr * 64 + m * 16 + fr; float s = 0.f;
#pragma unroll
                for (int bj = 0; bj < 2; ++bj) {
                    const pg8::f32x4 a0 = acc[ai][bj][m][0], a1 = acc[ai][bj][m][1];
                    s += (a0[0] * a0[0] + a0[1] * a0[1]) + (a0[2] * a0[2] + a0[3] * a0[3]) + (a1[0] * a1[0] + a1[1] * a1[1]) + (a1[2] * a1[2] + a1[3] * a1[3]);
                    u32x4 w; w.x = pkbf(a0[0], a0[1]); w.y = pkbf(a0[2], a0[3]); w.z = pkbf(a1[0], a1[1]); w.w = pkbf(a1[2], a1[3]);
                    *(u32x4*)(pe + (size_t)row * 1024 + cb + bj * 128) = w;
                }
                s += __shfl_xor(s, 16); s += __shfl_xor(s, 32);
                if (fq == 0) atomicAdd(ssq + row, s);
            }
    }
};
__device__ __forceinline__ void unpack8(const u32x4 w, f32x4& a0, f32x4& a1) {
    a0[0] = __uint_as_float(w.x << 16); a0[1] = __uint_as_float(w.x & 0xffff0000u); a0[2] = __uint_as_float(w.y << 16); a0[3] = __uint_as_float(w.y & 0xffff0000u);
    a1[0] = __uint_as_float(w.z << 16); a1[1] = __uint_as_float(w.z & 0xffff0000u); a1[2] = __uint_as_float(w.w << 16); a1[3] = __uint_as_float(w.w & 0xffff0000u);
}
struct EpiH1 {
    static constexpr bool PERM = true, AFTER_DRAIN = false;
    u16* hb; float* ssq;
    __device__ __forceinline__ void operator()(const pg8::f32x4 (&acc)[2][2][4][2], const pg8::Unit& u, int wr, int wc, int fr, int fq) const {
        const int cb = u.pn * 256 + wc * 32 + 8 * fq;
#pragma unroll
        for (int ai = 0; ai < 2; ++ai) {
            u32x4 hv[4][2];
#pragma unroll
            for (int m = 0; m < 4; ++m)
#pragma unroll
                for (int bj = 0; bj < 2; ++bj) hv[m][bj] = *(const u32x4*)(hb + (size_t)(u.pm * 256 + ai * 128 + wr * 64 + m * 16 + fr) * 1024 + cb + bj * 128);
#pragma unroll
            for (int m = 0; m < 4; ++m) {
                const int row = u.pm * 256 + ai * 128 + wr * 64 + m * 16 + fr; float s = 0.f;
#pragma unroll
                for (int bj = 0; bj < 2; ++bj) {
                    f32x4 a0, a1; unpack8(hv[m][bj], a0, a1);
                    a0 = a0 + acc[ai][bj][m][0]; a1 = a1 + acc[ai][bj][m][1];
                    s += (a0[0] * a0[0] + a0[1] * a0[1]) + (a0[2] * a0[2] + a0[3] * a0[3]) + (a1[0] * a1[0] + a1[1] * a1[1]) + (a1[2] * a1[2] + a1[3] * a1[3]);
                    u32x4 w; w.x = pkbf(a0[0], a0[1]); w.y = pkbf(a0[2], a0[3]); w.z = pkbf(a1[0], a1[1]); w.w = pkbf(a1[2], a1[3]);
                    *(u32x4*)(hb + (size_t)row * 1024 + cb + bj * 128) = w;
                }
                s += __shfl_xor(s, 16); s += __shfl_xor(s, 32);
                if (fq == 0) atomicAdd(ssq + row, s);
            }
        }
    }
};
struct EpiGate {
    static constexpr bool PERM = true, AFTER_DRAIN = false;
    const float* ssq1; const float* ssqpe; const float* gpost; const u16* pe; const u16* hin; u16* hb; float* ssq2;
    __device__ __forceinline__ void operator()(const pg8::f32x4 (&acc)[2][2][4][2], const pg8::Unit& u, int wr, int wc, int fr, int fq) const {
        const int cb = u.pn * 256 + wc * 32 + 8 * fq;
        f32x4 gp[2][2];
#pragma unroll
        for (int bj = 0; bj < 2; ++bj) { gp[bj][0] = *(const f32x4*)(gpost + cb + bj * 128); gp[bj][1] = *(const f32x4*)(gpost + cb + bj * 128 + 4); }
#pragma unroll
        for (int ai = 0; ai < 2; ++ai)
#pragma unroll
            for (int mp = 0; mp < 2; ++mp) {
                u32x4 hv[2][2], pv[2][2]; float r1[2], rp[2];
#pragma unroll
                for (int mm = 0; mm < 2; ++mm) { const int row = u.pm * 256 + ai * 128 + wr * 64 + (2 * mp + mm) * 16 + fr; r1[mm] = ssq1[row]; rp[mm] = ssqpe[row]; }
#pragma unroll
                for (int mm = 0; mm < 2; ++mm)
#pragma unroll
                    for (int bj = 0; bj < 2; ++bj) {
                        const size_t off = (size_t)(u.pm * 256 + ai * 128 + wr * 64 + (2 * mp + mm) * 16 + fr) * 1024 + cb + bj * 128;
                        hv[mm][bj] = *(const u32x4*)(hin + off); pv[mm][bj] = *(const u32x4*)(pe + off);
                    }
#pragma unroll
                for (int mm = 0; mm < 2; ++mm) {
                    const int m = 2 * mp + mm, row = u.pm * 256 + ai * 128 + wr * 64 + m * 16 + fr; float s = 0.f;
                    const float rs1 = rstd_of(r1[mm], 1024.f), rsp = rstd_of(rp[mm], 1024.f);
#pragma unroll
                    for (int bj = 0; bj < 2; ++bj) {
                        f32x4 a0, a1, p0, p1; unpack8(hv[mm][bj], a0, a1); unpack8(pv[mm][bj], p0, p1);
#pragma unroll
                        for (int j = 0; j < 4; ++j) {
                            a0[j] += sigmoid_f(acc[ai][bj][m][0][j] * rs1) * (p0[j] * rsp * gp[bj][0][j]);
                            a1[j] += sigmoid_f(acc[ai][bj][m][1][j] * rs1) * (p1[j] * rsp * gp[bj][1][j]);
                        }
                        s += (a0[0] * a0[0] + a0[1] * a0[1]) + (a0[2] * a0[2] + a0[3] * a0[3]) + (a1[0] * a1[0] + a1[1] * a1[1]) + (a1[2] * a1[2] + a1[3] * a1[3]);
                        u32x4 w; w.x = pkbf(a0[0], a0[1]); w.y = pkbf(a0[2], a0[3]); w.z = pkbf(a1[0], a1[1]); w.w = pkbf(a1[2], a1[3]);
                        *(u32x4*)(hb + (size_t)row * 1024 + cb + bj * 128) = w;
                    }
                    s += __shfl_xor(s, 16); s += __shfl_xor(s, 32);
                    if (fq == 0) atomicAdd(ssq2 + row, s);
                }
            }
    }
};
__device__ __forceinline__ float wave_sum(float v) {
#pragma unroll
    for (int o = 1; o < 64; o <<= 1) v += __shfl_xor(v, o);
    return v;
}
__device__ __forceinline__ void p0_transpose_item(const float* W, int K, int N, u16* WT, const float* scA, const float* scB, int split, LAS float* scr, int item, int lane) {
    const int nblk = N / 32, kb = item / nblk, nb = item % nblk, k0 = 64 * kb, n0 = 32 * nb;
    const int kr = lane >> 3, nc = (lane & 7) * 4;
    f32x4 v[8]; float sc[8];
#pragma unroll
    for (int i = 0; i < 8; ++i) { const int k = k0 + 8 * i + kr; v[i] = *(const f32x4*)(W + (size_t)k * N + n0 + nc); sc[i] = scA ? (k < split ? scA[k] : scB[k - split]) : 1.f; }
#pragma unroll
    for (int i = 0; i < 8; ++i) { LAS float* d = scr + (8 * i + kr) * 33 + nc; d[0] = v[i][0] * sc[i]; d[1] = v[i][1] * sc[i]; d[2] = v[i][2] * sc[i]; d[3] = v[i][3] * sc[i]; }
    asm volatile("s_waitcnt lgkmcnt(0)" ::: "memory");
    const int c = lane & 7;
#pragma unroll
    for (int j = 0; j < 4; ++j) {
        const int n = (lane >> 3) + 8 * j; const LAS float* s = scr + (8 * c) * 33 + n;
        u32x4 o; o.x = pkbf(s[0 * 33], s[1 * 33]); o.y = pkbf(s[2 * 33], s[3 * 33]); o.z = pkbf(s[4 * 33], s[5 * 33]); o.w = pkbf(s[6 * 33], s[7 * 33]);
        *(u32x4*)(WT + (size_t)(n0 + n) * K + k0 + 8 * c) = o;
    }
    asm volatile("s_waitcnt lgkmcnt(0)" ::: "memory");
}

__device__ __forceinline__ int crow(int r, int hi) { return (r & 3) + 8 * (r >> 2) + 4 * hi; }
#define MFMA32H(a, b, c) __builtin_amdgcn_mfma_f32_32x32x16_f16((a), (b), (c), 0, 0, 0)
__device__ __forceinline__ void attn_unit(int unit, LAS unsigned char* wl  , const u16* QBp, const u16* KBp, const u16* VBT, const u16* GBp, u16* Y) {
    int tid_ = threadIdx.x; asm volatile("" : "+v"(tid_));
    const int lane = tid_ & 63, q = lane & 31, hi = lane >> 5;
    const int bh = unit >> 7, qb = unit & 127, b = bh >> 3, h = bh & 7, t0 = qb * 32;
    const size_t rb = (size_t)b * SEQ;
    const u16* Qp = QBp + (rb + t0 + q) * 512 + h * 64 + 8 * hi;
    h8v qf[4];
#pragma unroll
    for (int c = 0; c < 4; ++c) qf[c] = *(const h8v*)(Qp + 16 * c);
    u32x2 gtw[2][4];
#pragma unroll
    for (int db = 0; db < 2; ++db)
#pragma unroll
        for (int r4 = 0; r4 < 4; ++r4) gtw[db][r4] = *(const u32x2*)(GBp + (rb + t0 + q) * 512 + h * 64 + 32 * db + 8 * r4 + 4 * hi);
    const u16* Kp = KBp + (rb + (lane >> 3)) * 512 + h * 64 + 8 * (lane & 7);
    const u16* Vp = VBT + ((size_t)(b * 512 + h * 64 + (lane >> 3))) * SEQ + 8 * (lane & 7);
    constexpr int AP = 144, AV = 64 * AP;
    LAS unsigned char* wst = wl + (lane >> 3) * AP + (lane & 7) * 16;
    const LAS unsigned char* kfr = wl + q * AP + 16 * hi;
    const LAS unsigned char* vfr = wl + AV + q * AP + 8 * hi;
    h8v um1;
#pragma unroll
    for (int i = 0; i < 8; ++i) um1[i] = (_Float16)(-1.f);
    f32x16 ot[2];
#pragma unroll
    for (int r = 0; r < 16; ++r) { ot[0][r] = 0.f; ot[1][r] = 0.f; }
    float R = 0.f;
#define ATT_LOADK(KR, KT) do { _Pragma("unroll") for (int i = 0; i < 8; ++i) KR[i] = *(const u32x4*)(Kp + (size_t)((KT) + 8 * i) * 512); } while (0)
#define ATT_LOADV(VR, KT) do { _Pragma("unroll") for (int i = 0; i < 8; ++i) VR[i] = *(const u32x4*)(Vp + (size_t)(8 * i) * SEQ + (KT)); } while (0)
    u32x4 kraw[8], vraw[8];
    int kt = t0 & ~63;
    ATT_LOADK(kraw, kt);
    for (;;) {
        const int ktn = kt - 64;
        ATT_LOADV(vraw, kt);
#pragma unroll
        for (int i = 0; i < 8; ++i) *(LAS u32x4*)(wst + i * 8 * AP) = kraw[i];
        if (ktn >= 0) ATT_LOADK(kraw, ktn);
        h8v kf[2][4];
#pragma unroll
        for (int blk = 0; blk < 2; ++blk)
#pragma unroll
            for (int c = 0; c < 4; ++c) kf[blk][c] = *(const LAS h8v*)(kfr + blk * 32 * AP + 32 * c);
        f32x16 sb[2];
#pragma unroll
        for (int blk = 0; blk < 2; ++blk) {
            f32x16 a;
#pragma unroll
            for (int r = 0; r < 16; ++r) a[r] = 0.f;
#pragma unroll
            for (int c = 0; c < 4; ++c) a = MFMA32H(kf[blk][c], qf[c], a);
            sb[blk] = a;
        }
        const bool diag = (kt + 64 > t0);
        const float tsave = sb[0][0];
        h8v lh[2][2];
#define ATT_SOFTPLUS(DIAG) do { _Pragma("unroll") for (int blk = 0; blk < 2; ++blk) _Pragma("unroll") for (int r = 0; r < 16; ++r) { \
            float l = lg2(1.f + ex2(fmin120(sb[blk][r]))); \
            if (DIAG) { if (kt + 32 * blk + crow(r, hi) >= t0 + q) l = 0.f; } \
            lh[blk][r >> 3][r & 7] = (_Float16)l; } } while (0)
        if (diag) { ATT_SOFTPLUS(1); } else { ATT_SOFTPLUS(0); }
#undef ATT_SOFTPLUS
        f32x16 c0 = sb[0], c1 = sb[1];
        h8v ud[2];
        { int qo = q; asm volatile("" : "+v"(qo));
#pragma unroll
          for (int cc = 0; cc < 2; ++cc)
#pragma unroll
            for (int i = 0; i < 8; ++i) ud[cc][i] = (crow(8 * cc + i, hi) >= qo) ? (_Float16)(-1.f) : (_Float16)0.f; }
        c0 = MFMA32H(ud[0], lh[0][0], c0); c0 = MFMA32H(ud[1], lh[0][1], c0); c0 = MFMA32H(um1, lh[1][0], c0); c0 = MFMA32H(um1, lh[1][1], c0);
        c1 = MFMA32H(ud[0], lh[1][0], c1); c1 = MFMA32H(ud[1], lh[1][1], c1);
        h8v wh[2][2];
#define ATT_WEIGHTS(DIAG) do { _Pragma("unroll") for (int r = 0; r < 16; ++r) { \
            float w0 = ex2(c0[r] + R), w1 = ex2(c1[r] + R); \
            if (DIAG) { if (kt + crow(r, hi) >= t0 + q) w0 = 0.f; if (kt + 32 + crow(r, hi) >= t0 + q) w1 = 0.f; } \
            wh[0][r >> 3][r & 7] = (_Float16)w0; wh[1][r >> 3][r & 7] = (_Float16)w1; } } while (0)
        if (diag) { ATT_WEIGHTS(1); } else { ATT_WEIGHTS(0); }
#undef ATT_WEIGHTS
        float tot = tsave - c0[0];
        tot = __shfl(tot, q);
        R -= tot;
#pragma unroll
        for (int i = 0; i < 8; ++i) *(LAS u32x4*)(wst + AV + i * 8 * AP) = vraw[i];
#pragma unroll
        for (int db = 0; db < 2; ++db)
#pragma unroll
            for (int blk = 0; blk < 2; ++blk)
#pragma unroll
                for (int cc = 0; cc < 2; ++cc) {
                    const LAS unsigned char* vp_ = vfr + db * 32 * AP + 64 * blk + 32 * cc;
                    const s4v lo_ = *(const LAS s4v*)vp_, hh_ = *(const LAS s4v*)(vp_ + 16);
                    ot[db] = MFMA32H(__builtin_bit_cast(h8v, __builtin_shufflevector(lo_, hh_, 0, 1, 2, 3, 4, 5, 6, 7)), wh[blk][cc], ot[db]);
                }
        if (ktn < 0 || !__any(R > ATT_THR)) break;
        kt = ktn;
    }
#undef ATT_LOADK
#undef ATT_LOADV
    float ss = 0.f;
#pragma unroll
    for (int r = 0; r < 16; ++r) ss += ot[0][r] * ot[0][r] + ot[1][r] * ot[1][r];
    ss += __shfl_xor(ss, 32);
    const float rs = rstd_of(ss, 64.f);
    const size_t row = rb + t0 + q;
#pragma unroll
    for (int db = 0; db < 2; ++db)
#pragma unroll
        for (int r4 = 0; r4 < 4; ++r4) {
            const int d = 32 * db + 8 * r4 + 4 * hi;
            const u32x2 gw = gtw[db][r4];
            const float g0 = __uint_as_float(gw.x << 16), g1 = __uint_as_float(gw.x & 0xffff0000u), g2 = __uint_as_float(gw.y << 16), g3 = __uint_as_float(gw.y & 0xffff0000u);
            u32x2 o; o.x = pkbf(ot[db][4 * r4 + 0] * rs * g0, ot[db][4 * r4 + 1] * rs * g1); o.y = pkbf(ot[db][4 * r4 + 2] * rs * g2, ot[db][4 * r4 + 3] * rs * g3);
            *(u32x2*)(Y + row * 1024 + 512 + h * 64 + d) = o;
        }
}

#define MFMA16B(a, b, c) __builtin_amdgcn_mfma_f32_16x16x32_bf16((a), (b), (c), 0, 0, 0)
constexpr int SC_QT = 0, SC_KT = 17408, SC_KTT = 34816, SC_PP = 53248, SC_FAC = 62464, SC_BSEG = 64000, SC_SSQ = 66048;
constexpr int SC_QP = 272, SC_TP = 144;
constexpr int NUNIT = BATCH * 4 * (SEQ / 64);

constexpr int SC_BSEG2 = 64000, SC_SSQ2 = 68096;
__device__ __forceinline__ void scanA_all(int bx, int G, LAS unsigned char* lds, const u16* KA, const u16* VAT, unsigned long long* UBUF, float* EBL) {
    int tid_ = threadIdx.x; asm volatile("" : "+v"(tid_));
    const int tid = tid_, lane = tid & 63, w = __builtin_amdgcn_readfirstlane(tid >> 6), l15 = lane & 15, g = lane >> 4, kp = lane;
    LAS float* FAC = (LAS float*)(lds + SC_FAC); LAS float* BSEG = (LAS float*)(lds + SC_BSEG2);
    unsigned rk[8];
    int unit = bx;
    if (unit < NUNIT) { const int bh = unit >> 6, c = unit & 63; const u16* kp_ = KA + ((size_t)(bh >> 2) * SEQ + c * 64 + 8 * w) * 512 + (bh & 3) * 128 + 2 * kp;
#pragma unroll
        for (int i = 0; i < 8; ++i) rk[i] = *(const unsigned*)(kp_ + i * 512); }
    for (; unit < NUNIT; unit += G) {
        const int bh = unit >> 6, c = unit & 63, b = bh >> 2, h = bh & 3, T0 = c * 64;
        const u16* vtp = VAT + ((size_t)(b * 512 + h * 128 + w * 16 + l15)) * SEQ + T0 + 8 * g;
        const s8v vt0 = *(const s8v*)vtp, vt1 = *(const s8v*)(vtp + 32);
        float k0[8], k1[8], cum0[8], cum1[8]; float c0 = 0.f, c1 = 0.f;
#pragma unroll
        for (int i = 0; i < 8; ++i) { k0[i] = h2f((u16)(rk[i] & 0xffffu)); k1[i] = h2f((u16)(rk[i] >> 16)); }
#pragma unroll
        for (int i = 0; i < 8; ++i) { c0 += lg2(1.f - k0[i]); c1 += lg2(1.f - k1[i]); cum0[i] = c0; cum1[i] = c1; }
        *(LAS f32x2*)(BSEG + w * 128 + 2 * kp) = (f32x2){c0, c1};
        { const int nu = unit + G; if (nu < NUNIT) { const int nbh = nu >> 6, nc = nu & 63; const u16* kp_ = KA + ((size_t)(nbh >> 2) * SEQ + nc * 64 + 8 * w) * 512 + (nbh & 3) * 128 + 2 * kp;
#pragma unroll
            for (int i = 0; i < 8; ++i) rk[i] = *(const unsigned*)(kp_ + i * 512); } }
        __syncthreads();
        {
            float pre0 = 0.f, pre1 = 0.f, bm0 = 0.f, bm1 = 0.f, bl0 = 0.f, bl1 = 0.f;
#pragma unroll
            for (int s = 0; s < 8; ++s) { const f32x2 v = *(const LAS f32x2*)(BSEG + s * 128 + 2 * kp);
                if (s < w) { pre0 += v[0]; pre1 += v[1]; } if (s < 4) { bm0 += v[0]; bm1 += v[1]; } bl0 += v[0]; bl1 += v[1]; }
            if (w == 0) { *(f32x2*)(EBL + (size_t)unit * 128 + 2 * kp) = (f32x2){ex2(bl0), ex2(bl1)}; *(LAS f32x2*)(FAC + 256 + 2 * kp) = (f32x2){ex2(bl0 - bm0), ex2(bl1 - bm1)}; }
            float a0[8], a1[8];
#pragma unroll
            for (int i = 0; i < 8; ++i) { a0[i] = k0[i] * ex2(fminf(bm0 - (pre0 + cum0[i]), 126.f)); a1[i] = k1[i] * ex2(fminf(bm1 - (pre1 + cum1[i]), 126.f)); }
            u32x4 p0, p1;
            p0.x = pkbf(a0[0], a0[1]); p0.y = pkbf(a0[2], a0[3]); p0.z = pkbf(a0[4], a0[5]); p0.w = pkbf(a0[6], a0[7]);
            p1.x = pkbf(a1[0], a1[1]); p1.y = pkbf(a1[2], a1[3]); p1.z = pkbf(a1[4], a1[5]); p1.w = pkbf(a1[6], a1[7]);
            *(LAS u32x4*)(lds + SC_KTT + (2 * kp) * SC_TP + 16 * w) = p0;
            *(LAS u32x4*)(lds + SC_KTT + (2 * kp + 1) * SC_TP + 16 * w) = p1;
        }
        __syncthreads();
        unsigned long long* up = UBUF + (((size_t)unit * 8 + w) * 8) * 64 + lane;
#pragma unroll
        for (int kb = 0; kb < 8; ++kb) {
            f32x4 ua = (f32x4){0.f, 0.f, 0.f, 0.f};
            ua = MFMA16B(*(const LAS s8v*)(lds + SC_KTT + (16 * kb + l15) * SC_TP + (8 * g) * 2), vt0, ua);
            ua = MFMA16B(*(const LAS s8v*)(lds + SC_KTT + (16 * kb + l15) * SC_TP + (32 + 8 * g) * 2), vt1, ua);
            const f32x4 e2 = *(const LAS f32x4*)(FAC + 256 + 16 * kb + 4 * g);
            ua = ua * e2;
            up[kb * 64] = (unsigned long long)pkbf(ua[0], ua[1]) | ((unsigned long long)pkbf(ua[2], ua[3]) << 32);
        }
    }
}

struct HalfSync { volatile LAS unsigned* cnt; unsigned target; };
template <bool DRAIN_VM = true> __device__ __forceinline__ void half_sync(HalfSync& hs) {
    if (DRAIN_VM) asm volatile("s_waitcnt vmcnt(0) lgkmcnt(0)" ::: "memory");
    else asm volatile("s_waitcnt lgkmcnt(0)" ::: "memory");
    hs.target += 4u;
    if ((threadIdx.x & 63) == 0) __hip_atomic_fetch_add((LAS unsigned*)hs.cnt, 1u, __ATOMIC_RELAXED, __HIP_MEMORY_SCOPE_WORKGROUP);
    unsigned spins = 0;
    while ((int)(*hs.cnt - hs.target) < 0) { __builtin_amdgcn_s_sleep(1); if (++spins > (1u << 24)) break; }
    asm volatile("" ::: "memory");
}
constexpr int SA4_KTT = 0, SA4_FAC = 18432, SA4_BSEG = 18944, SA4_ZS = 20992;
__device__ __forceinline__ void scanA4_all(int bx, int G, LAS unsigned char* zl0, HalfSync& hs, const u16* KA, const u16* VAT, unsigned long long* UBUF, float* EBL) {
    int tid_ = threadIdx.x; asm volatile("" : "+v"(tid_));
    const int lane = tid_ & 63, w4 = __builtin_amdgcn_readfirstlane((tid_ >> 6) - 4), l15 = lane & 15, g = lane >> 4, kp = lane;
    unsigned rk[2][16];
#define SA4_RAW(U, Z) do { const int bh_ = (U) >> 6, c_ = (U) & 63; const u16* kp_ = KA + ((size_t)(bh_ >> 2) * SEQ + c_ * 64 + 16 * w4) * 512 + (bh_ & 3) * 128 + 2 * kp; \
        _Pragma("unroll") for (int i = 0; i < 16; ++i) rk[Z][i] = *(const unsigned*)(kp_ + i * 512); } while (0)
    int ub = bx;
    if (ub < NUNIT) { SA4_RAW(ub, 0); const int u1 = (ub + G < NUNIT) ? ub + G : ub; SA4_RAW(u1, 1); }
    for (; ub < NUNIT; ub += 2 * G) {
        int un[2]; un[0] = ub; un[1] = (ub + G < NUNIT) ? ub + G : ub;
        s8v vt[2][2][2]; float cum0[2][16], cum1[2][16];
#pragma unroll
        for (int z = 0; z < 2; ++z) {
            const int unit = un[z], bh = unit >> 6, c = unit & 63, b = bh >> 2, h = bh & 3, T0 = c * 64;
            LAS float* BSEG = (LAS float*)(zl0 + z * SA4_ZS + SA4_BSEG);
#pragma unroll
            for (int y = 0; y < 2; ++y) { const u16* vtp = VAT + ((size_t)(b * 512 + h * 128 + (2 * w4 + y) * 16 + l15)) * SEQ + T0 + 8 * g; vt[z][y][0] = *(const s8v*)vtp; vt[z][y][1] = *(const s8v*)(vtp + 32); }
            float c0 = 0.f, c1 = 0.f;
#pragma unroll
            for (int i = 0; i < 16; ++i) { c0 += lg2(1.f - h2f((u16)(rk[z][i] & 0xffffu))); c1 += lg2(1.f - h2f((u16)(rk[z][i] >> 16))); cum0[z][i] = c0; cum1[z][i] = c1; }
            *(LAS f32x2*)(BSEG + w4 * 128 + 2 * kp) = (f32x2){c0, c1};
        }
        half_sync<false>(hs);
#pragma unroll
        for (int z = 0; z < 2; ++z) {
            const int unit = un[z];
            LAS unsigned char* zl = zl0 + z * SA4_ZS; LAS float* FAC = (LAS float*)(zl + SA4_FAC); LAS float* BSEG = (LAS float*)(zl + SA4_BSEG);
            float pre0 = 0.f, pre1 = 0.f, bm0 = 0.f, bm1 = 0.f, bl0 = 0.f, bl1 = 0.f;
#pragma unroll
            for (int s = 0; s < 4; ++s) { const f32x2 v = *(const LAS f32x2*)(BSEG + s * 128 + 2 * kp);
                if (s < w4) { pre0 += v[0]; pre1 += v[1]; } if (s < 2) { bm0 += v[0]; bm1 += v[1]; } bl0 += v[0]; bl1 += v[1]; }
            if (w4 == 0) { *(f32x2*)(EBL + (size_t)unit * 128 + 2 * kp) = (f32x2){ex2(bl0), ex2(bl1)}; *(LAS f32x2*)(FAC + 2 * kp) = (f32x2){ex2(bl0 - bm0), ex2(bl1 - bm1)}; }
#pragma unroll
            for (int hh = 0; hh < 2; ++hh) {
                float a0[8], a1[8];
#pragma unroll
                for (int i = 0; i < 8; ++i) { const unsigned r_ = rk[z][8 * hh + i];
                    a0[i] = h2f((u16)(r_ & 0xffffu)) * ex2(fminf(bm0 - (pre0 + cum0[z][8 * hh + i]), 126.f)); a1[i] = h2f((u16)(r_ >> 16)) * ex2(fminf(bm1 - (pre1 + cum1[z][8 * hh + i]), 126.f)); }
                u32x4 p0, p1;
                p0.x = pkbf(a0[0], a0[1]); p0.y = pkbf(a0[2], a0[3]); p0.z = pkbf(a0[4], a0[5]); p0.w = pkbf(a0[6], a0[7]);
                p1.x = pkbf(a1[0], a1[1]); p1.y = pkbf(a1[2], a1[3]); p1.z = pkbf(a1[4], a1[5]); p1.w = pkbf(a1[6], a1[7]);
                *(LAS u32x4*)(zl + SA4_KTT + (2 * kp) * SC_TP + 32 * w4 + 16 * hh) = p0;
                *(LAS u32x4*)(zl + SA4_KTT + (2 * kp + 1) * SC_TP + 32 * w4 + 16 * hh) = p1;
            }
        }
        { const int nb = ub + 2 * G; if (nb < NUNIT) { SA4_RAW(nb, 0); const int n1 = (nb + G < NUNIT) ? nb + G : nb; SA4_RAW(n1, 1); } }
        half_sync<false>(hs);
#pragma unroll
        for (int z = 0; z < 2; ++z) {
            const int unit = un[z];
            LAS unsigned char* zl = zl0 + z * SA4_ZS; LAS float* FAC = (LAS float*)(zl + SA4_FAC);
#pragma unroll
            for (int y = 0; y < 2; ++y) {
                unsigned long long* up = UBUF + (((size_t)unit * 8 + (2 * w4 + y)) * 8) * 64 + lane;
#pragma unroll
                for (int kb = 0; kb < 8; ++kb) {
                    f32x4 ua = (f32x4){0.f, 0.f, 0.f, 0.f};
                    ua = MFMA16B(*(const LAS s8v*)(zl + SA4_KTT + (16 * kb + l15) * SC_TP + (8 * g) * 2), vt[z][y][0], ua);
                    ua = MFMA16B(*(const LAS s8v*)(zl + SA4_KTT + (16 * kb + l15) * SC_TP + (32 + 8 * g) * 2), vt[z][y][1], ua);
                    const f32x4 e2 = *(const LAS f32x4*)(FAC + 16 * kb + 4 * g);
                    ua = ua * e2;
                    up[kb * 64] = (unsigned long long)pkbf(ua[0], ua[1]) | ((unsigned long long)pkbf(ua[2], ua[3]) << 32);
                }
            }
        }
    }
#undef SA4_RAW
}

__device__ __forceinline__ void scanB_all(int bx, int G, unsigned long long* UBUF, const float* EBL) {
    int tid_ = threadIdx.x; asm volatile("" : "+v"(tid_));
    constexpr int NSLOT = BATCH * 4 * 8 * 8 * 64;
    for (int s0 = bx * 256 + (tid_ & 255); s0 < NSLOT; s0 += 2 * G * 256) {
        const bool two = (s0 + G * 256 < NSLOT);
        const int sl[2] = {s0, two ? s0 + G * 256 : s0};
        unsigned long long* up[2]; const float* ep[2]; f32x4 S[2];
#pragma unroll
        for (int z = 0; z < 2; ++z) {
            const int slot = sl[z], ln = slot & 63, kb = (slot >> 6) & 7, w = (slot >> 9) & 7, bh = slot >> 12, g = ln >> 4;
            up[z] = UBUF + ((((size_t)bh * 64) * 8 + w) * 8 + kb) * 64 + ln;
            ep[z] = EBL + ((size_t)bh * 64) * 128 + 16 * kb + 4 * g;
            S[z] = (f32x4){0.f, 0.f, 0.f, 0.f};
        }
        for (int c0 = 0; c0 < 64; c0 += 8) {
            unsigned long long uv[2][8]; f32x4 ev[2][8];
#pragma unroll
            for (int z = 0; z < 2; ++z)
#pragma unroll
                for (int j = 0; j < 8; ++j) { uv[z][j] = up[z][(size_t)(c0 + j) * 4096]; ev[z][j] = *(const f32x4*)(ep[z] + (size_t)(c0 + j) * 128); }
#pragma unroll
            for (int z = 0; z < 2; ++z)
#pragma unroll
                for (int j = 0; j < 8; ++j) {
                    const unsigned lo = (unsigned)uv[z][j], hi = (unsigned)(uv[z][j] >> 32);
                    const f32x4 u4 = (f32x4){__uint_as_float(lo << 16), __uint_as_float(lo & 0xffff0000u), __uint_as_float(hi << 16), __uint_as_float(hi & 0xffff0000u)};
                    S[z] = ev[z][j] * S[z] + u4;
                    if (z == 0 || two) up[z][(size_t)(c0 + j) * 4096] = (unsigned long long)pkbf(S[z][0], S[z][1]) | ((unsigned long long)pkbf(S[z][2], S[z][3]) << 32);
                }
        }
    }
}

__device__ __forceinline__ void scanC_all(int bx, int G, LAS unsigned char* lds, const u16* QA, const u16* KA, const u16* VAT, const u16* GA, const unsigned long long* UBUF, u16* Y) {
    int tid_ = threadIdx.x; asm volatile("" : "+v"(tid_));
    const int tid = tid_, lane = tid & 63, w = __builtin_amdgcn_readfirstlane(tid >> 6), l15 = lane & 15, g = lane >> 4, kp = lane;
    LAS float* FAC = (LAS float*)(lds + SC_FAC); LAS float* BSEG = (LAS float*)(lds + SC_BSEG2); LAS float* SSQP = (LAS float*)(lds + SC_SSQ2);
    unsigned rk[8], rq[8];
    int unit = bx;
    if (unit < NUNIT) { const int bh = unit >> 6, c = unit & 63; const size_t o_ = ((size_t)(bh >> 2) * SEQ + c * 64 + 8 * w) * 512 + (bh & 3) * 128 + 2 * kp;
#pragma unroll
        for (int i = 0; i < 8; ++i) { rk[i] = *(const unsigned*)(KA + o_ + i * 512); rq[i] = *(const unsigned*)(QA + o_ + i * 512); } }
    for (; unit < NUNIT; unit += G) {
        const int bh = unit >> 6, c = unit & 63, b = bh >> 2, h = bh & 3, T0 = c * 64;
        const size_t rb = (size_t)b * SEQ;
        const u16* vtp = VAT + ((size_t)(b * 512 + h * 128 + w * 16 + l15)) * SEQ + T0 + 8 * g;
        const s8v vt0 = *(const s8v*)vtp, vt1 = *(const s8v*)(vtp + 32);
        unsigned long long sraw[8];
        { const unsigned long long* sp = UBUF + (((size_t)(c > 0 ? unit - 1 : unit) * 8 + w) * 8) * 64 + lane;
#pragma unroll
          for (int kb = 0; kb < 8; ++kb) { const unsigned long long v = sp[kb * 64]; sraw[kb] = (c > 0) ? v : 0ull; } }
        u32x2 gt[4];
#pragma unroll
        for (int ti = 0; ti < 4; ++ti) gt[ti] = *(const u32x2*)(GA + (rb + T0 + 16 * ti + l15) * 512 + h * 128 + 16 * w + 4 * g);
        float k0[8], k1[8], q0[8], q1[8], cum0[8], cum1[8]; float c0 = 0.f, c1 = 0.f;
#pragma unroll
        for (int i = 0; i < 8; ++i) { k0[i] = h2f((u16)(rk[i] & 0xffffu)); k1[i] = h2f((u16)(rk[i] >> 16)); q0[i] = __uint_as_float(rq[i] << 16); q1[i] = __uint_as_float(rq[i] & 0xffff0000u); }
#pragma unroll
        for (int i = 0; i < 8; ++i) { c0 += lg2(1.f - k0[i]); c1 += lg2(1.f - k1[i]); cum0[i] = c0; cum1[i] = c1; }
        *(LAS f32x2*)(BSEG + w * 128 + 2 * kp) = (f32x2){c0, c1};
        { const int nu = unit + G; if (nu < NUNIT) { const int nbh = nu >> 6, nc = nu & 63; const size_t o_ = ((size_t)(nbh >> 2) * SEQ + nc * 64 + 8 * w) * 512 + (nbh & 3) * 128 + 2 * kp;
#pragma unroll
            for (int i = 0; i < 8; ++i) { rk[i] = *(const unsigned*)(KA + o_ + i * 512); rq[i] = *(const unsigned*)(QA + o_ + i * 512); } } }
        __syncthreads();
        {
            float pre0 = 0.f, pre1 = 0.f, bm0 = 0.f, bm1 = 0.f;
#pragma unroll
            for (int s = 0; s < 7; ++s) { const f32x2 v = *(const LAS f32x2*)(BSEG + s * 128 + 2 * kp);
                if (s < w) { pre0 += v[0]; pre1 += v[1]; } if (s < 4) { bm0 += v[0]; bm1 += v[1]; } }
            if (w == 0) *(LAS f32x2*)(FAC + 2 * kp) = (f32x2){ex2(bm0), ex2(bm1)};
#pragma unroll
            for (int i = 0; i < 8; ++i) {
                const float d0 = pre0 + cum0[i] - bm0, d1 = pre1 + cum1[i] - bm1; const int t = 8 * w + i;
                *(LAS unsigned*)(lds + SC_QT + t * SC_QP + kp * 4) = pkbf(q0[i] * ex2(fminf(d0, 126.f)), q1[i] * ex2(fminf(d1, 126.f)));
                *(LAS unsigned*)(lds + SC_KT + t * SC_QP + kp * 4) = pkbf(k0[i] * ex2(fminf(-d0, 126.f)), k1[i] * ex2(fminf(-d1, 126.f)));
            }
        }
        __syncthreads();
        for (int id = w; id < 16; id += 8) {
            const int ti = id >> 2, sj = id & 3;
            f32x4 p = (f32x4){0.f, 0.f, 0.f, 0.f};
            if (sj <= ti) {
#pragma unroll
                for (int c4 = 0; c4 < 4; ++c4) {
                    const s8v a = *(const LAS s8v*)(lds + SC_KT + (16 * sj + l15) * SC_QP + (32 * c4 + 8 * g) * 2);
                    const s8v bb = *(const LAS s8v*)(lds + SC_QT + (16 * ti + l15) * SC_QP + (32 * c4 + 8 * g) * 2);
                    p = MFMA16B(a, bb, p);
                }
            }
            const int t = 16 * ti + l15, s0 = 16 * sj + 4 * g;
            u32x2 pw; pw.x = pkbf(s0 <= t ? p[0] : 0.f, s0 + 1 <= t ? p[1] : 0.f); pw.y = pkbf(s0 + 2 <= t ? p[2] : 0.f, s0 + 3 <= t ? p[3] : 0.f);
            *(LAS u32x2*)(lds + SC_PP + t * SC_TP + s0 * 2) = pw;
        }
        s8v sbf[4];
#pragma unroll
        for (int c4 = 0; c4 < 4; ++c4) {
            const f32x4 e0 = *(const LAS f32x4*)(FAC + 32 * c4 + 4 * g), e1 = *(const LAS f32x4*)(FAC + 32 * c4 + 16 + 4 * g);
            const unsigned a0 = (unsigned)sraw[2 * c4], a1 = (unsigned)(sraw[2 * c4] >> 32), b0 = (unsigned)sraw[2 * c4 + 1], b1 = (unsigned)(sraw[2 * c4 + 1] >> 32);
            u32x4 pk;
            pk.x = pkbf(__uint_as_float(a0 << 16) * e0[0], __uint_as_float(a0 & 0xffff0000u) * e0[1]); pk.y = pkbf(__uint_as_float(a1 << 16) * e0[2], __uint_as_float(a1 & 0xffff0000u) * e0[3]);
            pk.z = pkbf(__uint_as_float(b0 << 16) * e1[0], __uint_as_float(b0 & 0xffff0000u) * e1[1]); pk.w = pkbf(__uint_as_float(b1 << 16) * e1[2], __uint_as_float(b1 & 0xffff0000u) * e1[3]);
            sbf[c4] = __builtin_bit_cast(s8v, pk);
        }
        __syncthreads();
        f32x4 o[4];
#pragma unroll
        for (int ti = 0; ti < 4; ++ti) {
            f32x4 oo = (f32x4){0.f, 0.f, 0.f, 0.f};
            oo = MFMA16B(vt0, *(const LAS s8v*)(lds + SC_PP + (16 * ti + l15) * SC_TP + (8 * g) * 2), oo);
            oo = MFMA16B(vt1, *(const LAS s8v*)(lds + SC_PP + (16 * ti + l15) * SC_TP + (32 + 8 * g) * 2), oo);
#pragma unroll
            for (int c4 = 0; c4 < 4; ++c4) {
                const s4v lo = *(const LAS s4v*)(lds + SC_QT + (16 * ti + l15) * SC_QP + (32 * c4 + 4 * g) * 2);
                const s4v hh = *(const LAS s4v*)(lds + SC_QT + (16 * ti + l15) * SC_QP + (32 * c4 + 16 + 4 * g) * 2);
                oo = MFMA16B(sbf[c4], __builtin_shufflevector(lo, hh, 0, 1, 2, 3, 4, 5, 6, 7), oo);
            }
            o[ti] = oo;
        }
#pragma unroll
        for (int ti = 0; ti < 4; ++ti) {
            float s = (o[ti][0] * o[ti][0] + o[ti][1] * o[ti][1]) + (o[ti][2] * o[ti][2] + o[ti][3] * o[ti][3]);
            s += __shfl_xor(s, 16); s += __shfl_xor(s, 32);
            if (g == 0) SSQP[(16 * ti + l15) * 8 + w] = s;
        }
        __syncthreads();
#pragma unroll
        for (int ti = 0; ti < 4; ++ti) {
            const int t = 16 * ti + l15;
            const f32x4 s0 = *(const LAS f32x4*)(SSQP + t * 8), s1 = *(const LAS f32x4*)(SSQP + t * 8 + 4);
            const float rs = rstd_of((s0[0] + s0[1]) + (s0[2] + s0[3]) + (s1[0] + s1[1]) + (s1[2] + s1[3]), 128.f);
            const float g0 = __uint_as_float(gt[ti].x << 16), g1 = __uint_as_float(gt[ti].x & 0xffff0000u), g2 = __uint_as_float(gt[ti].y << 16), g3 = __uint_as_float(gt[ti].y & 0xffff0000u);
            u32x2 yo; yo.x = pkbf(o[ti][0] * rs * g0, o[ti][1] * rs * g1); yo.y = pkbf(o[ti][2] * rs * g2, o[ti][3] * rs * g3);
            *(u32x2*)(Y + (rb + T0 + t) * 1024 + h * 128 + 16 * w + 4 * g) = yo;
        }
    }
}

#define XB_TMO      128
#define XB_XCNT(j)  (256  + 64 * (j))
#define XB_XSUB(j)  (1280 + 64 * (j))
#define XB_XGEN(j)  (2304 + 64 * (j))
#define XB_TOP      3328
#define XB_TOPGEN   3392
#define XCD_BAR_WORDS 3456
#define XB_SPIN_CAP (1u << 18)

__device__ __forceinline__ unsigned xb_ld(unsigned* p)              { return __hip_atomic_load(p, __ATOMIC_RELAXED, __HIP_MEMORY_SCOPE_AGENT); }
__device__ __forceinline__ unsigned xb_add(unsigned* p, unsigned v) { return __hip_atomic_fetch_add(p, v, __ATOMIC_RELAXED, __HIP_MEMORY_SCOPE_AGENT); }
__device__ __forceinline__ unsigned xb_xcc_id() { return (unsigned)__builtin_amdgcn_s_getreg((3 << 11) | 20) & 0xFu; }
#define XB_SPIN(cond, bar) do { unsigned _sp = 0; while (cond) { __builtin_amdgcn_s_sleep(1); \
    if ((++_sp & 255u) == 0u) { if (xb_ld(&(bar)[XB_TMO])) break; if (_sp > XB_SPIN_CAP) { atomicAdd(&(bar)[XB_TMO], 1u); break; } } } } while (0)

struct XcdBarrier {
    unsigned* bar; unsigned x;
    volatile LAS unsigned* st;
};

__device__ __forceinline__ XcdBarrier xcd_barrier_post(unsigned* bar, volatile LAS unsigned* st) {
    XcdBarrier b; b.bar = bar; b.x = xb_xcc_id(); b.st = st;
    if (threadIdx.x == 0) (void)xb_add(&bar[XB_XCNT(b.x)], 1u);
    return b;
}
__device__ __forceinline__ void xcd_barrier_complete(unsigned* bar, unsigned x, unsigned& nloc, unsigned& nx) {
    const unsigned G = gridDim.x * gridDim.y * gridDim.z;
    unsigned sum, cnt, mine, sp = 0u;
    for (;;) {
        sum = 0u; cnt = 0u; mine = 0u;
#pragma unroll
        for (unsigned j = 0; j < 16; ++j) { const unsigned c = xb_ld(&bar[XB_XCNT(j)]); sum += c; cnt += (c > 0u) ? 1u : 0u; mine = (j == x) ? c : mine; }
        if (sum == G) break;
        __builtin_amdgcn_s_sleep(1);
        if ((++sp & 255u) == 0u) { if (xb_ld(&bar[XB_TMO])) break; if (sp > XB_SPIN_CAP) { atomicAdd(&bar[XB_TMO], 1u); break; } }
    }
    nloc = mine > 0u ? mine : 1u; nx = cnt > 0u ? cnt : 1u;
}

__device__ __forceinline__ void xcd_barrier(const XcdBarrier& b) {
    asm volatile("s_waitcnt vmcnt(0)" ::: "memory");
    __syncthreads();
    if (threadIdx.x == 0) {
        unsigned* bar = b.bar;
        __builtin_amdgcn_s_waitcnt(0);
        unsigned nloc = b.st[0], nx = b.st[1];
        if (nloc == 0u) { xcd_barrier_complete(bar, b.x, nloc, nx); b.st[0] = nloc; b.st[1] = nx; }
        const unsigned old = xb_add(&bar[XB_XSUB(b.x)], 1u);
        const unsigned gen = old / nloc;
        if (old + 1u == (gen + 1u) * nloc) {
            __builtin_amdgcn_fence(__ATOMIC_RELEASE, "agent");
            asm volatile("s_waitcnt vmcnt(0)" ::: "memory");
            const unsigned og = xb_add(&bar[XB_TOP], 1u);
            const unsigned tg = og / nx;
            if (og + 1u == (tg + 1u) * nx) xb_add(&bar[XB_TOPGEN], 1u);
            else XB_SPIN(xb_ld(&bar[XB_TOPGEN]) == tg, bar);
            __builtin_amdgcn_fence(__ATOMIC_ACQUIRE, "agent");
            xb_add(&bar[XB_XGEN(b.x)], 1u);
            asm volatile("s_waitcnt vmcnt(0)" ::: "memory");
        } else {
            XB_SPIN(xb_ld(&bar[XB_XGEN(b.x)]) == gen, bar);
            __builtin_amdgcn_fence(__ATOMIC_ACQUIRE, "agent");
            asm volatile("s_waitcnt vmcnt(0)" ::: "memory");
        }
    }
    __syncthreads();
}
__device__ __forceinline__ void xcd_barrier_upper(const XcdBarrier& b, HalfSync& hs) {
    half_sync(hs);
    if (threadIdx.x == 256) {
        unsigned* bar = b.bar;
        __builtin_amdgcn_s_waitcnt(0);
        unsigned nloc = b.st[0], nx = b.st[1];
        if (nloc == 0u) { xcd_barrier_complete(bar, b.x, nloc, nx); b.st[0] = nloc; b.st[1] = nx; }
        const unsigned old = xb_add(&bar[XB_XSUB(b.x)], 1u);
        const unsigned gen = old / nloc;
        if (old + 1u == (gen + 1u) * nloc) {
            __builtin_amdgcn_fence(__ATOMIC_RELEASE, "agent");
            asm volatile("s_waitcnt vmcnt(0)" ::: "memory");
            const unsigned og = xb_add(&bar[XB_TOP], 1u);
            const unsigned tg = og / nx;
            if (og + 1u == (tg + 1u) * nx) xb_add(&bar[XB_TOPGEN], 1u);
            else XB_SPIN(xb_ld(&bar[XB_TOPGEN]) == tg, bar);
            __builtin_amdgcn_fence(__ATOMIC_ACQUIRE, "agent");
            xb_add(&bar[XB_XGEN(b.x)], 1u);
            asm volatile("s_waitcnt vmcnt(0)" ::: "memory");
        } else {
            XB_SPIN(xb_ld(&bar[XB_XGEN(b.x)]) == gen, bar);
            __builtin_amdgcn_fence(__ATOMIC_ACQUIRE, "agent");
            asm volatile("s_waitcnt vmcnt(0)" ::: "memory");
        }
    }
    half_sync(hs);
}

#ifndef MK_MULTI
#define MK_MULTI 0
#endif
struct Args { const float* in[13]; float* out; unsigned char* ws; int ph_lo, ph_hi; };

__global__ void __launch_bounds__(512, 2) fwd_kernel(Args a) {
    extern __shared__ __attribute__((aligned(16))) unsigned char lds_raw[];
    LAS unsigned char* lds = (LAS unsigned char*)lds_raw;
    cg::grid_group grid = cg::this_grid();
    const int wave = __builtin_amdgcn_readfirstlane((int)threadIdx.x >> 6);
    const int G = gridDim.x, bx = blockIdx.x;
    const int gw = bx * 8 + wave, NGW = G * 8;
    unsigned char* ws = a.ws;
    unsigned* ctl = (unsigned*)(ws + WS_CTL);
    float* ssq = (float*)(ws + WS_CTL + CTL_SSQ);
    u16* WIN = (u16*)(ws + WS_WIN); u16* WOUT = (u16*)(ws + WS_WOUT); u16* WG = (u16*)(ws + WS_WG); u16* WP = (u16*)(ws + WS_WP);
    float* lbv = (float*)(ws + WS_SMALL);
    u16* PB = (u16*)(ws + WS_PB); u16* X0 = (u16*)(ws + WS_X0); u16* X1 = (u16*)(ws + WS_X1); u16* PROJ = (u16*)(ws + WS_PROJ); u16* PE = (u16*)(ws + WS_PE);
    const int lo = a.ph_lo, hi = a.ph_hi;
    volatile LAS unsigned* bst = (volatile LAS unsigned*)(lds + 147456 + 64);
    if (threadIdx.x < 8) bst[threadIdx.x] = 0u;
    __syncthreads();
    XcdBarrier xbar = xcd_barrier_post(ctl + 4096, bst);
    if (threadIdx.x == 256) (void)xb_add(&(ctl + 8192)[XB_XCNT(xbar.x)], 1u);
#define IN(k) (lo <= (k) && (k) < hi)
#define SEAM(k) do { if (IN(k) && IN((k) + 1)) { if (hi > 1000) grid.sync(); else xcd_barrier(xbar); } } while (0)

    if (IN(0)) {
        int tid_ = threadIdx.x; asm volatile("" : "+v"(tid_)); const int tid = tid_, lane = tid & 63;
        {
        LAS float* scr = (LAS float*)(lds + wave * 16384);
        constexpr int I_IN0 = (DM / 64) * (DIN / 32);
        for (int it = gw; it < I_IN0; it += NGW) p0_transpose_item(a.in[3], DM, DIN, WIN, a.in[2], nullptr, DM, scr, it, lane);
        for (int m0 = gw * 2; m0 < MTOK; m0 += NGW * 2) {
            f32x4 v[2][4];
#pragma unroll
            for (int r = 0; r < 2; ++r)
#pragma unroll
                for (int j = 0; j < 4; ++j) v[r][j] = *((const f32x4*)(a.in[0] + (size_t)(m0 + r) * DM) + lane + 64 * j);
#pragma unroll
            for (int r = 0; r < 2; ++r) {
                unsigned long long* o8 = (unsigned long long*)(X0 + (size_t)(m0 + r) * DM) + lane; float s = 0.f;
#pragma unroll
                for (int j = 0; j < 4; ++j) { const f32x4 x = v[r][j]; s += (x[0] * x[0] + x[1] * x[1]) + (x[2] * x[2] + x[3] * x[3]);
                    o8[64 * j] = (unsigned long long)pkbf(x[0], x[1]) | ((unsigned long long)pkbf(x[2], x[3]) << 32); }
                s = wave_sum(s);
                if (lane == 0) ssq[m0 + r] = s;
            }
        }
        if (bx == 0) { const float l0 = a.in[7][tid], l1 = a.in[7][512 + tid]; lbv[tid] = 1.f; lbv[512 + tid] = 1.f - 1.f / (1.f + __expf(l0 - l1)); }
        __syncthreads();
        }
    }
    SEAM(0);

    for (int l = 0; l < DEPTH; ++l) {
        const int pb = 1 + 5 * l;
        u16* XA = (l & 1) ? X1 : X0;
        u16* XB = (l & 1) ? X0 : X1;
        float* ssq_in = ssq + (size_t)(l == 0 ? 0 : 3 + 3 * (l - 1)) * MTOK;
        float* ssq_pe = ssq + (size_t)(1 + 3 * l) * MTOK; float* ssq_h1 = ssq + (size_t)(2 + 3 * l) * MTOK; float* ssq_h2 = ssq + (size_t)(3 + 3 * l) * MTOK;
        if (IN(pb)) {
            { pg8::Gemm g{XA, WIN + (size_t)l * DIN * DM, MTOK, DIN, DM}; pg8::StaticOrder S; S.init(MTOK, DIN, G, bx);
              EpiProj E{ssq_in, lbv + l * 512, PROJ};
              pg8::gemm_phase<EpiProj, pg8::StaticOrder, true, true>(lds, g, S, E);
            }
        }
        SEAM(pb);
        unsigned long long* UBUF = (unsigned long long*)a.out;
        float* EBL = (float*)(ws + WS_EBL);
        if (IN(pb + 1)) {
            if (wave < 4) {
                const int vcu = (G % 8 == 0) ? (bx % 8) * (G / 8) + bx / 8 : bx;
                    for (int u = vcu * 4 + wave; u < BATCH * 8 * (SEQ / 32); u += G * 4) {
                        attn_unit(u, lds + wave * 18432, PROJ + 4 * SEGSZ, PROJ + 5 * SEGSZ, PROJ + 6 * SEGSZ, PROJ + 7 * SEGSZ, XB);
                    }
            } else {
                volatile LAS unsigned* bst2 = (volatile LAS unsigned*)(lds + 147456 + 64);
                XcdBarrier ubar; ubar.bar = ctl + 8192; ubar.x = xb_xcc_id(); ubar.st = bst2 + 2;
                const int nu4 = (bx < NUNIT) ? ((NUNIT - bx + G - 1) / G + 1) / 2 : 0;
                HalfSync hs; hs.cnt = bst2 + 4; hs.target = (unsigned)(l * 4 * (2 * nu4 + 3));
                scanA4_all(bx, G, lds + 73728, hs, PROJ + 1 * SEGSZ, PROJ + 2 * SEGSZ, UBUF, EBL);
                xcd_barrier_upper(ubar, hs);
                scanB_all(bx, G, UBUF, EBL);
                half_sync<false>(hs);
                {
                    int tq_ = threadIdx.x; asm volatile("" : "+v"(tq_)); const int t4 = tq_ & 255, ln = tq_ & 63;
                    LAS float* scr = (LAS float*)(lds + 73728 + (wave - 4) * 16384);
                    const int gw4 = bx * 4 + (wave - 4), NGW4 = G * 4;
                    constexpr int I_IN = (DM / 64) * (DIN / 32), I_SQ = (DM / 64) * (DM / 32), I_P = (DPLE / 64) * (DM / 32);
                    const int nit = 2 * I_SQ + I_P + ((l + 1 < DEPTH) ? I_IN : 0);
                    for (int it = gw4; it < nit; it += NGW4) {
                        int r = it;
                        if (r < I_SQ) { p0_transpose_item(a.in[6] + (size_t)l * DM * DM, DM, DM, WOUT + (size_t)l * DM * DM, a.in[4] + l * 512, a.in[5] + l * 512, 512, scr, r, ln); continue; } r -= I_SQ;
                        if (r < I_SQ) { p0_transpose_item(a.in[9] + (size_t)l * DM * DM, DM, DM, WG + (size_t)l * DM * DM, a.in[8] + l * DM, nullptr, DM, scr, r, ln); continue; } r -= I_SQ;
                        if (r < I_P) { p0_transpose_item(a.in[10] + (size_t)l * DPLE * DM, DPLE, DM, WP + (size_t)l * DM * DPLE, nullptr, nullptr, 0, scr, r, ln); continue; } r -= I_P;
                        p0_transpose_item(a.in[3] + (size_t)(l + 1) * DM * DIN, DM, DIN, WIN + (size_t)(l + 1) * DIN * DM, a.in[2] + (l + 1) * DM, nullptr, DM, scr, r, ln);
                    }
                    const size_t NP = (size_t)MTOK * DPLE / 8, ST = (size_t)G * 256;
                    const f32x4* src = (const f32x4*)(a.in[1] + (size_t)l * MTOK * DPLE); u32x4* dst = (u32x4*)(PB + (size_t)l * MTOK * DPLE);
                    size_t i = (size_t)bx * 256 + t4;
                    for (; i + 7 * ST < NP; i += 8 * ST) {
                        f32x4 v0[8], v1[8];
#pragma unroll
                        for (int j = 0; j < 8; ++j) { const size_t ii = i + j * ST; v0[j] = src[2 * ii]; v1[j] = src[2 * ii + 1]; }
#pragma unroll
                        for (int j = 0; j < 8; ++j) { const size_t ii = i + j * ST; u32x4 o; o.x = pkbf(v0[j][0], v0[j][1]); o.y = pkbf(v0[j][2], v0[j][3]); o.z = pkbf(v1[j][0], v1[j][1]); o.w = pkbf(v1[j][2], v1[j][3]); dst[ii] = o; }
                    }
                    for (; i < NP; i += ST) { const f32x4 v0 = src[2 * i], v1 = src[2 * i + 1]; u32x4 o; o.x = pkbf(v0[0], v0[1]); o.y = pkbf(v0[2], v0[3]); o.z = pkbf(v1[0], v1[1]); o.w = pkbf(v1[2], v1[3]); dst[i] = o; }
                }
            }
            __syncthreads();
        }
        SEAM(pb + 1);
        if (IN(pb + 2)) {
            scanC_all(bx, G, lds, PROJ + 0 * SEGSZ, PROJ + 1 * SEGSZ, PROJ + 2 * SEGSZ, PROJ + 3 * SEGSZ, UBUF, XB);
            __syncthreads();
        }
        SEAM(pb + 2);
        if (IN(pb + 3)) {
            pg8::Gemm g{XB, WOUT + (size_t)l * DM * DM, MTOK, DM, DM}; pg8::StaticOrder S; S.init(MTOK, DM, G, bx);
            EpiH1 E{XA, ssq_h1};
            pg8::gemm_phase<EpiH1, pg8::StaticOrder, true, true>(lds, g, S, E);
            { int kple = DPLE; asm volatile("" : "+s"(kple));
              pg8::Gemm g{PB + (size_t)l * MTOK * DPLE, WP + (size_t)l * DM * DPLE, MTOK, DM, kple}; pg8::StaticOrder S; S.init(MTOK, DM, G, bx);
              EpiPe E{PE, ssq_pe};
              pg8::gemm_phase<EpiPe, pg8::StaticOrder, true, true>(lds, g, S, E);
            }
        }
        SEAM(pb + 3);
        if (IN(pb + 4)) {
            pg8::Gemm g{XA, WG + (size_t)l * DM * DM, MTOK, DM, DM}; pg8::StaticOrder S; S.init(MTOK, DM, G, bx);
            EpiGate E{ssq_h1, ssq_pe, a.in[11] + l * DM, PE, XA, XB, ssq_h2};
            pg8::gemm_phase<EpiGate, pg8::StaticOrder, true, true>(lds, g, S, E);
        }
        SEAM(pb + 4);
    }
    if (IN(NPHASE - 1)) {
        int tidf_ = threadIdx.x; asm volatile("" : "+v"(tidf_)); const int lane = tidf_ & 63;
        const float* sq = ssq + (size_t)(3 + 3 * (DEPTH - 1)) * MTOK;
        const u16* HL = ((DEPTH - 1) & 1) ? X0 : X1;
        for (int m0 = gw * 2; m0 < MTOK; m0 += NGW * 2) {
            u32x4 hv[2][2]; float sv[2];
#pragma unroll
            for (int r = 0; r < 2; ++r) { sv[r] = sq[m0 + r];
#pragma unroll
                for (int j = 0; j < 2; ++j) hv[r][j] = *(const u32x4*)(HL + (size_t)(m0 + r) * DM + 512 * j + 8 * lane); }
#pragma unroll
            for (int r = 0; r < 2; ++r) { const float rs = rstd_of(sv[r], 1024.f);
#pragma unroll
                for (int j = 0; j < 2; ++j) { f32x4 a0, a1; unpack8(hv[r][j], a0, a1);
                    const f32x4 g0 = *(const f32x4*)(a.in[12] + 512 * j + 8 * lane), g1 = *(const f32x4*)(a.in[12] + 512 * j + 8 * lane + 4);
                    float* op = a.out + (size_t)(m0 + r) * DM + 512 * j + 8 * lane;
                    *(f32x4*)op = a0 * rs * g0; *(f32x4*)(op + 4) = a1 * rs * g1; } }
        }
    }
#undef IN
#undef SEAM
}

extern "C" void kernel_launch(void* const* d_in, const int* in_sizes, int n_in, void* d_out, int out_size, void* d_ws, size_t ws_size, hipStream_t stream) {
    static int grid = 0;
    if (grid == 0) {
        if (n_in != 13 || in_sizes[0] != MTOK * DM || out_size != MTOK * DM || ws_size < WS_END) {
            fprintf(stderr, "kernel_launch: unexpected shapes (n_in %d, in0 %d, out %d, ws %zu); nothing launched\n", n_in, n_in > 0 ? in_sizes[0] : -1, out_size, ws_size); grid = -1; return; }
        int dev = 0, cus = 0, per_cu = 0;
        hipGetDevice(&dev);
        hipDeviceGetAttribute(&cus, hipDeviceAttributeMultiprocessorCount, dev);
        if (hipFuncSetAttribute((const void*)fwd_kernel, hipFuncAttributeMaxDynamicSharedMemorySize, LDS_BYTES) != hipSuccess) { fprintf(stderr, "kernel_launch: hipFuncSetAttribute failed\n"); grid = -1; return; }
        if (hipOccupancyMaxActiveBlocksPerMultiprocessor(&per_cu, (const void*)fwd_kernel, 512, LDS_BYTES) != hipSuccess || per_cu < 1) { fprintf(stderr, "kernel_launch: occupancy query gave %d\n", per_cu); per_cu = 1; }
        (void)hipGetLastError();
        grid = cus * per_cu;
        if (grid < 32) { fprintf(stderr, "kernel_launch: grid %d too small\n", grid); grid = -1; return; }
    }
    if (grid < 0) return;
    (void)hipMemsetAsync((char*)d_ws + WS_CTL, 0, CTL_BYTES, stream);
    Args a{};
    for (int i = 0; i < 13; ++i) a.in[i] = (const float*)d_in[i];
    a.out = (float*)d_out; a.ws = (unsigned char*)d_ws;
#if MK_MULTI
    for (int ph = 0; ph < NPHASE; ++ph) { a.ph_lo = ph; a.ph_hi = ph + 1; hipLaunchKernelGGL(fwd_kernel, dim3(grid), dim3(512), LDS_BYTES, stream, a); }
#else
    a.ph_lo = 0; a.ph_hi = NPHASE;
    void* args[] = {&a};
    hipError_t e = hipLaunchCooperativeKernel((const void*)fwd_kernel, dim3(grid), dim3(512), args, LDS_BYTES, stream);
    if (e != hipSuccess) fprintf(stderr, "kernel_launch: cooperative launch failed: %s (grid %d)\n", hipGetErrorString(e), grid);
#endif
}
```

```cpp
#include <hip/hip_runtime.h>
#include <hip/hip_cooperative_groups.h>
#include <cstdio>
#include <cstdint>
namespace cg = cooperative_groups;
#define MK_MULTI 0
namespace pg8 {
#define PG8_LAS __attribute__((address_space(3)))
typedef unsigned short bf16_t;
typedef short bf16x8 __attribute__((ext_vector_type(8)));
typedef float f32x4 __attribute__((ext_vector_type(4)));
typedef unsigned u32x4 __attribute__((ext_vector_type(4)));
constexpr int BM = 256, BK = 64, HALF = 128, HTB = HALF * BK * 2  , STAGE_BYTES = 8 * HTB, NXCD = 8, WGM = 8;

__host__ __device__ __forceinline__ int lds_byte(int r, int c) { const int st = (r >> 4) * 2 + (c >> 5), rr = r & 15, cc = c & 31, ob = rr * 64 + cc * 2; return st * 1024 + (ob ^ (((ob >> 9) & 1) << 5)); }
__host__ __device__ __forceinline__ void stage_rc(int b, int& R, int& C) { const int st = b / 1024, sb = b % 1024, swz = sb ^ (((sb >> 9) & 1) << 5); R = (st >> 1) * 16 + swz / 64; C = (st & 1) * 32 + (swz % 64) / 2; }
__host__ __device__ __forceinline__ int perm32(int rho) { const int n = rho >> 4, i = rho & 15; return 8 * (i >> 2) + 4 * n + (i & 3); }

struct Unit { int pm, pn; };
struct Gemm { const bf16_t* A; const bf16_t* Bt; int M, N, K; };

struct StaticOrder {
    int nM, nN, nwg, G, c;
    __host__ __device__ void init(int M, int N, int G_, int c_) { nM = M / BM; nN = N / BM; nwg = nM * nN; G = G_; c = c_; }
    __host__ __device__ bool next(int i, Unit& u) const {
        const long L = (long)i * G + c; if (L >= nwg) return false;
        int wgid = (int)L; { const int q = nwg / NXCD, r = nwg % NXCD, xcd = wgid % NXCD, off = wgid / NXCD; wgid = (xcd < r ? xcd * (q + 1) : r * (q + 1) + (xcd - r) * q) + off; }
        const int nig = WGM * nN, gid = wgid / nig, fm = gid * WGM, gsz = (nM - fm) < WGM ? (nM - fm) : WGM;
        u.pm = fm + ((wgid % nig) % gsz); u.pn = (wgid % nig) / gsz; return true;
    }
    __device__ __forceinline__ void a_ready(const Unit&) const {}
    __device__ __forceinline__ void done(const Unit&) const {}
};

__device__ __forceinline__ unsigned cvt_pk_bf16(float lo, float hi) { unsigned r; asm volatile("v_cvt_pk_bf16_f32 %0, %1, %2" : "=v"(r) : "v"(lo), "v"(hi)); return r; }
typedef float f32x2 __attribute__((ext_vector_type(2)));
template <class Epi, class Sched, bool ALIGN_EPI = false, bool SP2 = false>
__device__ __forceinline__ void gemm_phase(PG8_LAS unsigned char* lds, const Gemm g, const Sched& S, const Epi& E) {
    int tid_ = threadIdx.x; asm volatile("" : "+v"(tid_));
    const int tid = tid_, wid = __builtin_amdgcn_readfirstlane(tid >> 6), lane = tid & 63, wr = wid >> 2, wc = wid & 3, fr = lane & 15, fq = lane >> 4;
    const int K = g.K, nt = K / BK;
    unsigned voffA[2], voffB[2];
#pragma unroll
    for (int i = 0; i < 2; ++i) { int R, C; stage_rc(tid * 16 + i * 8192, R, C); const int Rb = Epi::PERM ? ((R & ~31) + perm32(R & 31)) : R;
        voffA[i] = (unsigned)(R * K + C) * 2u; voffB[i] = (unsigned)(Rb * K + C) * 2u; }
    const size_t kstep = (size_t)(BK * 2);
    const size_t hstep = (size_t)HALF * K * 2;
    const size_t tstep = 2 * hstep;
    const unsigned ldsw = (unsigned)wid * 1024u;
    const int aoff = lds_byte(wr * 64 + fr, fq * 8), boff = lds_byte(wc * 32 + fr, fq * 8);
#define PG8_SA(b, h) (((b) * 2 + (h)) * HTB)
#define PG8_SB(b, h) ((4 + (b) * 2 + (h)) * HTB)
#define PG8_STAGE(bufoff, gbase, voff) do { _Pragma("unroll") for (int _i = 0; _i < 2; ++_i) \
        __builtin_amdgcn_global_load_lds((const unsigned*)((const char*)(gbase) + (voff)[_i]), (PG8_LAS unsigned*)(lds + (bufoff) + ldsw + _i * 8192), 16, 0, 0); } while (0)
#define PG8_LDA(dst, b, h) do { _Pragma("unroll") for (int m = 0; m < 4; ++m) _Pragma("unroll") for (int k = 0; k < 2; ++k) dst[m][k] = *(const PG8_LAS bf16x8*)(lds + PG8_SA(b, h) + aoff + m * 2048 + k * 1024); } while (0)
#define PG8_LDB(dst, b, h) do { _Pragma("unroll") for (int n = 0; n < 2; ++n) _Pragma("unroll") for (int k = 0; k < 2; ++k) dst[n][k] = *(const PG8_LAS bf16x8*)(lds + PG8_SB(b, h) + boff + n * 2048 + k * 1024); } while (0)
#define PG8_MMA(ai, bj, At, Bt) do { __builtin_amdgcn_s_setprio(1); _Pragma("unroll") for (int m = 0; m < 4; ++m) _Pragma("unroll") for (int n = 0; n < 2; ++n) _Pragma("unroll") for (int k = 0; k < 2; ++k) \
        acc[ai][bj][m][n] = __builtin_amdgcn_mfma_f32_16x16x32_bf16(Bt[n][k], At[m][k], acc[ai][bj][m][n], 0, 0, 0); __builtin_amdgcn_s_setprio(0); } while (0)
#define PG8_WAIT_V(n) asm volatile("s_waitcnt vmcnt(" #n ")" ::: "memory")
#define PG8_WAIT_L(n) asm volatile("s_waitcnt lgkmcnt(" #n ")" ::: "memory")
#define PG8_BAR __builtin_amdgcn_s_barrier()
#define PG8_SCHED __builtin_amdgcn_sched_barrier(0)
    Unit cur, nxt; int ui = 0;
    if (!S.next(0, cur)) return;
    f32x4 acc[2][2][4][2];
#pragma unroll
    for (int a = 0; a < 2; ++a)
#pragma unroll
        for (int b = 0; b < 2; ++b)
#pragma unroll
            for (int m = 0; m < 4; ++m)
#pragma unroll
                for (int n = 0; n < 2; ++n) acc[a][b][m][n] = (f32x4){0.f, 0.f, 0.f, 0.f};
    bf16x8 At[4][2], B0[2][2], B1[2][2];
    const char* cA = (const char*)g.A + (size_t)cur.pm * tstep; const char* cB = (const char*)g.Bt + (size_t)cur.pn * tstep;
    S.a_ready(cur);
    if constexpr (SP2) {
        PG8_STAGE(PG8_SB(0, 0), cB, voffB); PG8_STAGE(PG8_SB(0, 1), cB + hstep, voffB); PG8_STAGE(PG8_SA(0, 0), cA, voffA); PG8_STAGE(PG8_SA(0, 1), cA + hstep, voffA);
        if (wr == 1) PG8_BAR;
        PG8_WAIT_V(2); PG8_BAR;
        PG8_STAGE(PG8_SB(1, 0), cB + kstep, voffB); PG8_STAGE(PG8_SA(1, 0), cA + kstep, voffA); PG8_STAGE(PG8_SB(1, 1), cB + hstep + kstep, voffB);
        PG8_WAIT_V(6); PG8_BAR;
    } else {
        PG8_STAGE(PG8_SB(0, 0), cB, voffB); PG8_STAGE(PG8_SA(0, 0), cA, voffA); PG8_STAGE(PG8_SB(0, 1), cB + hstep, voffB); PG8_STAGE(PG8_SA(0, 1), cA + hstep, voffA);
        if (wr == 1) PG8_BAR;
        PG8_WAIT_V(4); PG8_BAR;
        PG8_STAGE(PG8_SB(1, 0), cB + kstep, voffB); PG8_STAGE(PG8_SA(1, 0), cA + kstep, voffA); PG8_STAGE(PG8_SB(1, 1), cB + hstep + kstep, voffB);
        PG8_WAIT_V(6); PG8_BAR;
    }
    for (;;) {
        const bool has_next = S.next(ui + 1, nxt);
        const char* nA = has_next ? (const char*)g.A + (size_t)nxt.pm * tstep : cA; const char* nB = has_next ? (const char*)g.Bt + (size_t)nxt.pn * tstep : cB;
        for (int t = 0; t < nt; t += 2) {
            const bool last = (t == nt - 2);
            const char* a1 = cA + (size_t)(t + 1) * kstep;
            const char* a2 = last ? nA : cA + (size_t)(t + 2) * kstep; const char* b2 = last ? nB : cB + (size_t)(t + 2) * kstep;
            const char* a3 = a2 + kstep; const char* b3 = b2 + kstep;
            if (last && has_next) S.a_ready(nxt);
            if constexpr (SP2) {
            PG8_LDB(B0, 0, 0); PG8_LDB(B1, 0, 1); PG8_SCHED; PG8_LDA(At, 0, 0); PG8_STAGE(PG8_SA(1, 1), a1 + hstep, voffA);
            PG8_WAIT_V(8); PG8_WAIT_L(0); PG8_BAR; PG8_MMA(0, 0, At, B0); PG8_MMA(0, 1, At, B1); PG8_BAR; PG8_SCHED;
            PG8_LDA(At, 0, 1); PG8_STAGE(PG8_SB(0, 0), b2, voffB); PG8_STAGE(PG8_SB(0, 1), b2 + hstep, voffB); PG8_STAGE(PG8_SA(0, 0), a2, voffA);
            PG8_WAIT_V(8); PG8_WAIT_L(0); PG8_BAR; PG8_MMA(1, 0, At, B0); PG8_MMA(1, 1, At, B1); PG8_BAR; PG8_SCHED;
            PG8_LDB(B0, 1, 0); PG8_LDB(B1, 1, 1); PG8_SCHED; PG8_LDA(At, 1, 0); PG8_STAGE(PG8_SA(0, 1), a2 + hstep, voffA);
            PG8_WAIT_V(8); PG8_WAIT_L(0); PG8_BAR; PG8_MMA(0, 0, At, B0); PG8_MMA(0, 1, At, B1); PG8_BAR; PG8_SCHED;
            PG8_LDA(At, 1, 1); PG8_STAGE(PG8_SB(1, 0), b3, voffB); PG8_STAGE(PG8_SB(1, 1), b3 + hstep, voffB); PG8_STAGE(PG8_SA(1, 0), a3, voffA);
            PG8_WAIT_V(8); PG8_WAIT_L(0); PG8_BAR; PG8_MMA(1, 0, At, B0); PG8_MMA(1, 1, At, B1); PG8_BAR; PG8_SCHED;
            } else {
            PG8_LDB(B0, 0, 0); PG8_SCHED; PG8_LDA(At, 0, 0); PG8_STAGE(PG8_SA(1, 1), a1 + hstep, voffA);
            PG8_WAIT_L(8); PG8_BAR; PG8_WAIT_L(0); PG8_MMA(0, 0, At, B0); PG8_BAR; PG8_SCHED;
            PG8_LDB(B1, 0, 1); PG8_STAGE(PG8_SB(0, 0), b2, voffB);
            PG8_BAR; PG8_WAIT_L(0); PG8_MMA(0, 1, At, B1); PG8_BAR;
            PG8_LDA(At, 0, 1); PG8_STAGE(PG8_SA(0, 0), a2, voffA);
            PG8_BAR; PG8_WAIT_L(0); PG8_MMA(1, 0, At, B0); PG8_BAR; PG8_SCHED;
            PG8_STAGE(PG8_SB(0, 1), b2 + hstep, voffB);
            PG8_WAIT_V(6); PG8_BAR; PG8_MMA(1, 1, At, B1); PG8_BAR;
            PG8_LDB(B0, 1, 0); PG8_SCHED; PG8_LDA(At, 1, 0); PG8_STAGE(PG8_SA(0, 1), a2 + hstep, voffA);
            PG8_WAIT_L(8); PG8_BAR; PG8_WAIT_L(0); PG8_MMA(0, 0, At, B0); PG8_BAR; PG8_SCHED;
            PG8_LDB(B1, 1, 1); PG8_STAGE(PG8_SB(1, 0), b3, voffB);
            PG8_BAR; PG8_WAIT_L(0); PG8_MMA(0, 1, At, B1); PG8_BAR;
            PG8_LDA(At, 1, 1); PG8_STAGE(PG8_SA(1, 0), a3, voffA);
            PG8_BAR; PG8_WAIT_L(0); PG8_MMA(1, 0, At, B0); PG8_BAR; PG8_SCHED;
            PG8_STAGE(PG8_SB(1, 1), b3 + hstep, voffB);
            PG8_WAIT_V(6); PG8_BAR; PG8_MMA(1, 1, At, B1); PG8_BAR;
            }
        }
        if constexpr (ALIGN_EPI) { if (wr == 0) PG8_BAR; }
        if constexpr (!Epi::AFTER_DRAIN) { E(acc, cur, wr, wc, fr, fq); S.done(cur); }
        if (!has_next) break;
#pragma unroll
        for (int a = 0; a < 2; ++a)
#pragma unroll
            for (int b = 0; b < 2; ++b)
#pragma unroll
                for (int m = 0; m < 4; ++m)
#pragma unroll
                    for (int n = 0; n < 2; ++n) acc[a][b][m][n] = (f32x4){0.f, 0.f, 0.f, 0.f};
        cur = nxt; cA = nA; cB = nB; ++ui;
        if constexpr (ALIGN_EPI) { if (wr == 1) PG8_BAR; }
    }
    PG8_WAIT_V(0);
    if constexpr (!ALIGN_EPI) { if (wr == 0) PG8_BAR; }
    PG8_BAR;
    if constexpr (Epi::AFTER_DRAIN) { E.fused(acc, cur, wr, wc, fr, fq, lds, wid, lane); S.done(cur); }
#undef PG8_SA
#undef PG8_SB
#undef PG8_STAGE
#undef PG8_LDA
#undef PG8_LDB
#undef PG8_MMA
#undef PG8_WAIT_V
#undef PG8_WAIT_L
#undef PG8_BAR
#undef PG8_SCHED
}
}

constexpr int BATCH = 8, SEQ = 4096, DM = 1024, MTOK = BATCH * SEQ, DEPTH = 2, DIN = 4096, DPLE = 256;
constexpr float EPS = 1e-6f;
constexpr float LOG2E = 1.4426950408889634f;
constexpr float QSCALE = 0.125f * LOG2E;
#define LAS __attribute__((address_space(3)))
typedef unsigned short u16;
typedef short s8v __attribute__((ext_vector_type(8)));
typedef short s4v __attribute__((ext_vector_type(4)));
typedef _Float16 h8v __attribute__((ext_vector_type(8)));
typedef _Float16 h2v __attribute__((ext_vector_type(2)));
typedef float f32x2 __attribute__((ext_vector_type(2)));
typedef float f32x4 __attribute__((ext_vector_type(4)));
typedef float f32x16 __attribute__((ext_vector_type(16)));
typedef unsigned u32x4 __attribute__((ext_vector_type(4)));
typedef unsigned u32x2 __attribute__((ext_vector_type(2)));

constexpr size_t MiB = 1u << 20;
constexpr size_t WS_CTL = 0, CTL_BYTES = 1 * MiB;
constexpr size_t WS_WIN = 1 * MiB;
constexpr size_t WS_WOUT = 17 * MiB;
constexpr size_t WS_WG = 21 * MiB;
constexpr size_t WS_WP = 25 * MiB;
constexpr size_t WS_SMALL = 26 * MiB;
constexpr size_t WS_PB = 27 * MiB;
constexpr size_t WS_X0 = 59 * MiB, WS_X1 = 123 * MiB;
constexpr size_t WS_PROJ = 187 * MiB;
constexpr size_t WS_PE = 443 * MiB;
constexpr size_t WS_EBL = 507 * MiB;
constexpr size_t WS_END = 509 * MiB;
constexpr size_t CTL_SSQ = 65536;
constexpr size_t SEGSZ = (size_t)MTOK * 512;
constexpr int LDS_BYTES = 148480;
constexpr int NPHASE = 12;
#define ATT_THR -150.f

__device__ __forceinline__ float bf2f(u16 u) { return __uint_as_float((unsigned)u << 16); }
__device__ __forceinline__ float h2f(u16 u) { return (float)__builtin_bit_cast(_Float16, u); }
__device__ __forceinline__ unsigned pkbf(float lo, float hi) { unsigned r; asm volatile("v_cvt_pk_bf16_f32 %0, %1, %2" : "=v"(r) : "v"(lo), "v"(hi)); return r; }
__device__ __forceinline__ u16 f2bf(float f) { return (u16)(pkbf(f, 0.f) & 0xffffu); }
__device__ __forceinline__ unsigned pkh(float lo, float hi) { h2v v = {(_Float16)lo, (_Float16)hi}; return __builtin_bit_cast(unsigned, v); }
__device__ __forceinline__ float ex2(float x) { return __builtin_amdgcn_exp2f(x); }
__device__ __forceinline__ float lg2(float x) { return __builtin_amdgcn_logf(x); }
__device__ __forceinline__ float fmin120(float a) { float r; asm("v_min_f32 %0, 0x42f00000, %1" : "=v"(r) : "v"(a)); return r; }
__device__ __forceinline__ float sigmoid_f(float v) { return __builtin_amdgcn_rcpf(1.f + ex2(-v * LOG2E)); }
__device__ __forceinline__ float silu_f(float v) { return v * sigmoid_f(v); }
__device__ __forceinline__ float rstd_of(float ssq, float n) { return __builtin_amdgcn_rsqf(ssq * (1.f / n) + EPS); }

struct EpiProj {
    static constexpr bool PERM = true, AFTER_DRAIN = false;
    const float* ssq; const float* lbv; u16* proj;
    __device__ __forceinline__ void operator()(const pg8::f32x4 (&acc)[2][2][4][2], const pg8::Unit& u, int wr, int wc, int fr, int fq) const {
        const int seg = u.pn >> 1;
        u16* dst = proj + (size_t)seg * SEGSZ;
        const int cb = (u.pn & 1) * 256 + wc * 32 + 8 * fq;
        const bool isf16 = (seg == 1) | (seg == 4) | (seg == 5) | (seg == 6);
        const bool tr = (seg == 2) | (seg == 6);
        const bool dosilu = (seg == 0) | (seg == 3) | (seg == 7);
        float lb8[2][8];
#pragma unroll
        for (int bj = 0; bj < 2; ++bj)
#pragma unroll
            for (int j = 0; j < 8; ++j) lb8[bj][j] = (seg == 1) ? lbv[cb + bj * 128 + j] : 1.f;
        float rsv[2][4];
#pragma unroll
        for (int ai = 0; ai < 2; ++ai)
#pragma unroll
            for (int m = 0; m < 4; ++m) rsv[ai][m] = ssq[u.pm * 256 + ai * 128 + wr * 64 + m * 16 + fr];
#pragma unroll
        for (int ai = 0; ai < 2; ++ai)
#pragma unroll
            for (int m = 0; m < 4; ++m) {
                const int row = u.pm * 256 + ai * 128 + wr * 64 + m * 16 + fr;
                const float rs = rstd_of(rsv[ai][m], 1024.f);
#pragma unroll
                for (int bj = 0; bj < 2; ++bj) {
                    float v[8];
#pragma unroll
                    for (int n = 0; n < 2; ++n)
#pragma unroll
                        for (int j = 0; j < 4; ++j) v[4 * n + j] = acc[ai][bj][m][n][j] * rs;
                    if (dosilu) {
#pragma unroll
                        for (int j = 0; j < 8; ++j) v[j] = silu_f(v[j]);
                    } else if (seg == 1) {
#pragma unroll
                        for (int j = 0; j < 8; ++j) v[j] = fminf(lb8[bj][j] * sigmoid_f(-v[j]), 0.9995f);
                    } else if (seg == 4) {
#pragma unroll
                        for (int j = 0; j < 8; ++j) v[j] *= QSCALE;
                    }
                    u32x4 w;
                    if (isf16) { w.x = pkh(v[0], v[1]); w.y = pkh(v[2], v[3]); w.z = pkh(v[4], v[5]); w.w = pkh(v[6], v[7]); }
                    else { w.x = pkbf(v[0], v[1]); w.y = pkbf(v[2], v[3]); w.z = pkbf(v[4], v[5]); w.w = pkbf(v[6], v[7]); }
                    if (!tr) { *(u32x4*)(dst + (size_t)row * 512 + cb + bj * 128) = w; }
                    else {
                        u16* p = dst + ((size_t)((row >> 12) * 512 + cb + bj * 128)) * SEQ + (row & 4095);
                        p[0 * SEQ] = (u16)(w.x & 0xffffu); p[1 * SEQ] = (u16)(w.x >> 16); p[2 * SEQ] = (u16)(w.y & 0xffffu); p[3 * SEQ] = (u16)(w.y >> 16);
                        p[4 * SEQ] = (u16)(w.z & 0xffffu); p[5 * SEQ] = (u16)(w.z >> 16); p[6 * SEQ] = (u16)(w.w & 0xffffu); p[7 * SEQ] = (u16)(w.w >> 16);
                    }
                }
            }
    }
};
struct EpiPe {
    static constexpr bool PERM = true, AFTER_DRAIN = false;
    u16* pe; float* ssq;
    __device__ __forceinline__ void operator()(const pg8::f32x4 (&acc)[2][2][4][2], const pg8::Unit& u, int wr, int wc, int fr, int fq) const {
        const int cb = u.pn * 256 + wc * 32 + 8 * fq;
#pragma unroll
        for (int ai = 0; ai < 2; ++ai)
#pragma unroll
            for (int m = 0; m < 4; ++m) {
                const int row = u.pm * 256 + ai * 128 + wr * 64 + m * 16 + fr; float s = 0.f;
#pragma unroll
                for (int bj = 0; bj < 2; ++bj) {
                    const pg8::f32x4 a0 = acc[ai][bj][m][0], a1 = acc[ai][bj][m][1];
                    s += (a0[0] * a0[0] + a0[1] * a0[1]) + (a0[2] * a0[2] + a0[3] * a0[3]) + (a1[0] * a1[0] + a1[1] * a1[1]) + (a1[2] * a1[2] + a1[3] * a1[3]);
                    u32x4 w; w.x = pkbf(a0[0], a0[1]); w.y = pkbf(a0[2], a0[3]); w.z = pkbf(a1[0], a1[1]); w.w = pkbf(a1[2], a1[3]);
                    *(u32x4*)(pe + (size_t)row * 1024 + cb + bj * 128) = w;
                }
                s += __shfl_xor(s, 16); s += __shfl_xor(s, 32);
                if (fq == 0) atomicAdd(ssq + row, s);
            }
    }
};
__device__ __forceinline__ void unpack8(const u32x4 w, f32x4& a0, f32x4& a1) {
    a0[0] = __uint_as_float(w.x << 16); a0[1] = __uint_as_float(w.x & 0xffff0000u); a0[2] = __uint_as_float(w.y << 16); a0[3] = __uint_as_float(w.y & 0xffff0000u);
    a1[0] = __uint_as_float(w.z << 16); a1[1] = __uint_as_float(w.z & 0xffff0000u); a1[2] = __uint_as_float(w.w << 16); a1[3] = __uint_as_float(w.w & 0xffff0000u);
}
struct EpiH1 {
    static constexpr bool PERM = true, AFTER_DRAIN = false;
    u16* hb; float* ssq;
    __device__ __forceinline__ void operator()(const pg8::f32x4 (&acc)[2][2][4][2], const pg8::Unit& u, int wr, int wc, int fr, int fq) const {
        const int cb = u.pn * 256 + wc * 32 + 8 * fq;
#pragma unroll
        for (int ai = 0; ai < 2; ++ai) {
            u32x4 hv[4][2];
#pragma unroll
            for (int m = 0; m < 4; ++m)
#pragma unroll
                for (int bj = 0; bj < 2; ++bj) hv[m][bj] = *(const u32x4*)(hb + (size_t)(u.pm * 256 + ai * 128 + wr * 64 + m * 16 + fr) * 1024 + cb + bj * 128);
#pragma unroll
            for (int m = 0; m < 4; ++m) {
                const int row = u.pm * 256 + ai * 128 + wr * 64 + m * 16 + fr; float s = 0.f;
#pragma unroll
                for (int bj = 0; bj < 2; ++bj) {
                    f32x4 a0, a1; unpack8(hv[m][bj], a0, a1);
                    a0 = a0 + acc[ai][bj][m][0]; a1 = a1 + acc[ai][bj][m][1];
                    s += (a0[0] * a0[0] + a0[1] * a0[1]) + (a0[2] * a0[2] + a0[3] * a0[3]) + (a1[0] * a1[0] + a1[1] * a1[1]) + (a1[2] * a1[2] + a1[3] * a1[3]);
                    u32x4 w; w.x = pkbf(a0[0], a0[1]); w.y = pkbf(a0[2], a0[3]); w.z = pkbf(a1[0], a1[1]); w.w = pkbf(a1[2], a1[3]);
                    *(u32x4*)(hb + (size_t)row * 1024 + cb + bj * 128) = w;
                }
                s += __shfl_xor(s, 16); s += __shfl_xor(s, 32);
                if (fq == 0) atomicAdd(ssq + row, s);
            }
        }
    }
};
struct EpiGate {
    static constexpr bool PERM = true, AFTER_DRAIN = false;
    const float* ssq1; const float* ssqpe; const float* gpost; const u16* pe; const u16* hin; u16* hb; float* ssq2;
    __device__ __forceinline__ void operator()(const pg8::f32x4 (&acc)[2][2][4][2], const pg8::Unit& u, int wr, int wc, int fr, int fq) const {
        const int cb = u.pn * 256 + wc * 32 + 8 * fq;
        f32x4 gp[2][2];
#pragma unroll
        for (int bj = 0; bj < 2; ++bj) { gp[bj][0] = *(const f32x4*)(gpost + cb + bj * 128); gp[bj][1] = *(const f32x4*)(gpost + cb + bj * 128 + 4); }
#pragma unroll
        for (int ai = 0; ai < 2; ++ai)
#pragma unroll
            for (int mp = 0; mp < 2; ++mp) {
                u32x4 hv[2][2], pv[2][2]; float r1[2], rp[2];
#pragma unroll
                for (int mm = 0; mm < 2; ++mm) { const int row = u.pm * 256 + ai * 128 + wr * 64 + (2 * mp + mm) * 16 + fr; r1[mm] = ssq1[row]; rp[mm] = ssqpe[row]; }
#pragma unroll
                for (int mm = 0; mm < 2; ++mm)
#pragma unroll
                    for (int bj = 0; bj < 2; ++bj) {
                        const size_t off = (size_t)(u.pm * 256 + ai * 128 + wr * 64 + (2 * mp + mm) * 16 + fr) * 1024 + cb + bj * 128;
                        hv[mm][bj] = *(const u32x4*)(hin + off); pv[mm][bj] = *(const u32x4*)(pe + off);
                    }
#pragma unroll
                for (int mm = 0; mm < 2; ++mm) {
                    const int m = 2 * mp + mm, row = u.pm * 256 + ai * 128 + wr * 64 + m * 16 + fr; float s = 0.f;
                    const float rs1 = rstd_of(r1[mm], 1024.f), rsp = rstd_of(rp[mm], 1024.f);
#pragma unroll
                    for (int bj = 0; bj < 2; ++bj) {
                        f32x4 a0, a1, p0, p1; unpack8(hv[mm][bj], a0, a1); unpack8(pv[mm][bj], p0, p1);
#pragma unroll
                        for (int j = 0; j < 4; ++j) {
                            a0[j] += sigmoid_f(acc[ai][bj][m][0][j] * rs1) * (p0[j] * rsp * gp[bj][0][j]);
                            a1[j] += sigmoid_f(acc[ai][bj][m][1][j] * rs1) * (p1[j] * rsp * gp[bj][1][j]);
                        }
                        s += (a0[0] * a0[0] + a0[1] * a0[1]) + (a0[2] * a0[2] + a0[3] * a0[3]) + (a1[0] * a1[0] + a1[1] * a1[1]) + (a1[2] * a1[2] + a1[3] * a1[3]);
                        u32x4 w; w.x = pkbf(a0[0], a0[1]); w.y = pkbf(a0[2], a0[3]); w.z = pkbf(a1[0], a1[1]); w.w = pkbf(a1[2], a1[3]);
                        *(u32x4*)(hb + (size_t)row * 1024 + cb + bj * 128) = w;
                    }
                    s += __shfl_xor(s, 16); s += __shfl_xor(s, 32);
                    if (fq == 0) atomicAdd(ssq2 + row, s);
                }
            }
    }
};
__device__ __forceinline__ float wave_sum(float v) {
#pragma unroll
    for (int o = 1; o < 64; o <<= 1) v += __shfl_xor(v, o);
    return v;
}
__device__ __forceinline__ void p0_transpose_item(const float* W, int K, int N, u16* WT, const float* scA, const float* scB, int split, LAS float* scr, int item, int lane) {
    const int nblk = N / 32, kb = item / nblk, nb = item % nblk, k0 = 64 * kb, n0 = 32 * nb;
    const int kr = lane >> 3, nc = (lane & 7) * 4;
    f32x4 v[8]; float sc[8];
#pragma unroll
    for (int i = 0; i < 8; ++i) { const int k = k0 + 8 * i + kr; v[i] = *(const f32x4*)(W + (size_t)k * N + n0 + nc); sc[i] = scA ? (k < split ? scA[k] : scB[k - split]) : 1.f; }
#pragma unroll
    for (int i = 0; i < 8; ++i) { LAS float* d = scr + (8 * i + kr) * 33 + nc; d[0] = v[i][0] * sc[i]; d[1] = v[i][1] * sc[i]; d[2] = v[i][2] * sc[i]; d[3] = v[i][3] * sc[i]; }
    asm volatile("s_waitcnt lgkmcnt(0)" ::: "memory");
    const int c = lane & 7;
#pragma unroll
    for (int j = 0; j < 4; ++j) {
        const int n = (lane >> 3) + 8 * j; const LAS float* s = scr + (8 * c) * 33 + n;
        u32x4 o; o.x = pkbf(s[0 * 33], s[1 * 33]); o.y = pkbf(s[2 * 33], s[3 * 33]); o.z = pkbf(s[4 * 33], s[5 * 33]); o.w = pkbf(s[6 * 33], s[7 * 33]);
        *(u32x4*)(WT + (size_t)(n0 + n) * K + k0 + 8 * c) = o;
    }
    asm volatile("s_waitcnt lgkmcnt(0)" ::: "memory");
}

__device__ __forceinline__ int crow(int r, int hi) { return (r & 3) + 8 * (r >> 2) + 4 * hi; }
#define MFMA32H(a, b, c) __builtin_amdgcn_mfma_f32_32x32x16_f16((a), (b), (c), 0, 0, 0)
__device__ __forceinline__ void attn_unit(int unit, LAS unsigned char* wl  , const u16* QBp, const u16* KBp, const u16* VBT, const u16* GBp, u16* Y) {
    int tid_ = threadIdx.x; asm volatile("" : "+v"(tid_));
    const int lane = tid_ & 63, q = lane & 31, hi = lane >> 5;
    const int bh = unit >> 7, qb = unit & 127, b = bh >> 3, h = bh & 7, t0 = qb * 32;
    const size_t rb = (size_t)b * SEQ;
    const u16* Qp = QBp + (rb + t0 + q) * 512 + h * 64 + 8 * hi;
    h8v qf[4];
#pragma unroll
    for (int c = 0; c < 4; ++c) qf[c] = *(const h8v*)(Qp + 16 * c);
    u32x2 gtw[2][4];
#pragma unroll
    for (int db = 0; db < 2; ++db)
#pragma unroll
        for (int r4 = 0; r4 < 4; ++r4) gtw[db][r4] = *(const u32x2*)(GBp + (rb + t0 + q) * 512 + h * 64 + 32 * db + 8 * r4 + 4 * hi);
    const u16* Kp = KBp + (rb + (lane >> 3)) * 512 + h * 64 + 8 * (lane & 7);
    const u16* Vp = VBT + ((size_t)(b * 512 + h * 64 + (lane >> 3))) * SEQ + 8 * (lane & 7);
    constexpr int AP = 144, AV = 64 * AP;
    LAS unsigned char* wst = wl + (lane >> 3) * AP + (lane & 7) * 16;
    const LAS unsigned char* kfr = wl + q * AP + 16 * hi;
    const LAS unsigned char* vfr = wl + AV + q * AP + 8 * hi;
    h8v um1;
#pragma unroll
    for (int i = 0; i < 8; ++i) um1[i] = (_Float16)(-1.f);
    f32x16 ot[2];
#pragma unroll
    for (int r = 0; r < 16; ++r) { ot[0][r] = 0.f; ot[1][r] = 0.f; }
    float R = 0.f;
#define ATT_LOADK(KR, KT) do { _Pragma("unroll") for (int i = 0; i < 8; ++i) KR[i] = *(const u32x4*)(Kp + (size_t)((KT) + 8 * i) * 512); } while (0)
#define ATT_LOADV(VR, KT) do { _Pragma("unroll") for (int i = 0; i < 8; ++i) VR[i] = *(const u32x4*)(Vp + (size_t)(8 * i) * SEQ + (KT)); } while (0)
    u32x4 kraw[8], vraw[8];
    int kt = t0 & ~63;
    ATT_LOADK(kraw, kt);
    for (;;) {
        const int ktn = kt - 64;
        ATT_LOADV(vraw, kt);
#pragma unroll
        for (int i = 0; i < 8; ++i) *(LAS u32x4*)(wst + i * 8 * AP) = kraw[i];
        if (ktn >= 0) ATT_LOADK(kraw, ktn);
        h8v kf[2][4];
#pragma unroll
        for (int blk = 0; blk < 2; ++blk)
#pragma unroll
            for (int c = 0; c < 4; ++c) kf[blk][c] = *(const LAS h8v*)(kfr + blk * 32 * AP + 32 * c);
        f32x16 sb[2];
#pragma unroll
        for (int blk = 0; blk < 2; ++blk) {
            f32x16 a;
#pragma unroll
            for (int r = 0; r < 16; ++r) a[r] = 0.f;
#pragma unroll
            for (int c = 0; c < 4; ++c) a = MFMA32H(kf[blk][c], qf[c], a);
            sb[blk] = a;
        }
        const bool diag = (kt + 64 > t0);
        const float tsave = sb[0][0];
        h8v lh[2][2];
#define ATT_SOFTPLUS(DIAG) do { _Pragma("unroll") for (int blk = 0; blk < 2; ++blk) _Pragma("unroll") for (int r = 0; r < 16; ++r) { \
            float l = lg2(1.f + ex2(fmin120(sb[blk][r]))); \
            if (DIAG) { if (kt + 32 * blk + crow(r, hi) >= t0 + q) l = 0.f; } \
            lh[blk][r >> 3][r & 7] = (_Float16)l; } } while (0)
        if (diag) { ATT_SOFTPLUS(1); } else { ATT_SOFTPLUS(0); }
#undef ATT_SOFTPLUS
        f32x16 c0 = sb[0], c1 = sb[1];
        h8v ud[2];
        { int qo = q; asm volatile("" : "+v"(qo));
#pragma unroll
          for (int cc = 0; cc < 2; ++cc)
#pragma unroll
            for (int i = 0; i < 8; ++i) ud[cc][i] = (crow(8 * cc + i, hi) >= qo) ? (_Float16)(-1.f) : (_Float16)0.f; }
        c0 = MFMA32H(ud[0], lh[0][0], c0); c0 = MFMA32H(ud[1], lh[0][1], c0); c0 = MFMA32H(um1, lh[1][0], c0); c0 = MFMA32H(um1, lh[1][1], c0);
        c1 = MFMA32H(ud[0], lh[1][0], c1); c1 = MFMA32H(ud[1], lh[1][1], c1);
        h8v wh[2][2];
#define ATT_WEIGHTS(DIAG) do { _Pragma("unroll") for (int r = 0; r < 16; ++r) { \
            float w0 = ex2(c0[r] + R), w1 = ex2(c1[r] + R); \
            if (DIAG) { if (kt + crow(r, hi) >= t0 + q) w0 = 0.f; if (kt + 32 + crow(r, hi) >= t0 + q) w1 = 0.f; } \
            wh[0][r >> 3][r & 7] = (_Float16)w0; wh[1][r >> 3][r & 7] = (_Float16)w1; } } while (0)
        if (diag) { ATT_WEIGHTS(1); } else { ATT_WEIGHTS(0); }
#undef ATT_WEIGHTS
        float tot = tsave - c0[0];
        tot = __shfl(tot, q);
        R -= tot;
#pragma unroll
        for (int i = 0; i < 8; ++i) *(LAS u32x4*)(wst + AV + i * 8 * AP) = vraw[i];
#pragma unroll
        for (int db = 0; db < 2; ++db)
#pragma unroll
            for (int blk = 0; blk < 2; ++blk)
#pragma unroll
                for (int cc = 0; cc < 2; ++cc) {
                    const LAS unsigned char* vp_ = vfr + db * 32 * AP + 64 * blk + 32 * cc;
                    const s4v lo_ = *(const LAS s4v*)vp_, hh_ = *(const LAS s4v*)(vp_ + 16);
                    ot[db] = MFMA32H(__builtin_bit_cast(h8v, __builtin_shufflevector(lo_, hh_, 0, 1, 2, 3, 4, 5, 6, 7)), wh[blk][cc], ot[db]);
                }
        if (ktn < 0 || !__any(R > ATT_THR)) break;
        kt = ktn;
    }
#undef ATT_LOADK
#undef ATT_LOADV
    float ss = 0.f;
#pragma unroll
    for (int r = 0; r < 16; ++r) ss += ot[0][r] * ot[0][r] + ot[1][r] * ot[1][r];
    ss += __shfl_xor(ss, 32);
    const float rs = rstd_of(ss, 64.f);
    const size_t row = rb + t0 + q;
#pragma unroll
    for (int db = 0; db < 2; ++db)
#pragma unroll
        for (int r4 = 0; r4 < 4; ++r4) {
            const int d = 32 * db + 8 * r4 + 4 * hi;
            const u32x2 gw = gtw[db][r4];
            const float g0 = __uint_as_float(gw.x << 16), g1 = __uint_as_float(gw.x & 0xffff0000u), g2 = __uint_as_float(gw.y << 16), g3 = __uint_as_float(gw.y & 0xffff0000u);
            u32x2 o; o.x = pkbf(ot[db][4 * r4 + 0] * rs * g0, ot[db][4 * r4 + 1] * rs * g1); o.y = pkbf(ot[db][4 * r4 + 2] * rs * g2, ot[db][4 * r4 + 3] * rs * g3);
            *(u32x2*)(Y + row * 1024 + 512 + h * 64 + d) = o;
        }
}

#define MFMA16B(a, b, c) __builtin_amdgcn_mfma_f32_16x16x32_bf16((a), (b), (c), 0, 0, 0)
constexpr int SC_QT = 0, SC_KT = 17408, SC_KTT = 34816, SC_PP = 53248, SC_FAC = 62464, SC_BSEG = 64000, SC_SSQ = 66048;
constexpr int SC_QP = 272, SC_TP = 144;
constexpr int NUNIT = BATCH * 4 * (SEQ / 64);

constexpr int SC_BSEG2 = 64000, SC_SSQ2 = 68096;
__device__ __forceinline__ void scanA_all(int bx, int G, LAS unsigned char* lds, const u16* KA, const u16* VAT, unsigned long long* UBUF, float* EBL) {
    int tid_ = threadIdx.x; asm volatile("" : "+v"(tid_));
    const int tid = tid_, lane = tid & 63, w = __builtin_amdgcn_readfirstlane(tid >> 6), l15 = lane & 15, g = lane >> 4, kp = lane;
    LAS float* FAC = (LAS float*)(lds + SC_FAC); LAS float* BSEG = (LAS float*)(lds + SC_BSEG2);
    unsigned rk[8];
    int unit = bx;
    if (unit < NUNIT) { const int bh = unit >> 6, c = unit & 63; const u16* kp_ = KA + ((size_t)(bh >> 2) * SEQ + c * 64 + 8 * w) * 512 + (bh & 3) * 128 + 2 * kp;
#pragma unroll
        for (int i = 0; i < 8; ++i) rk[i] = *(const unsigned*)(kp_ + i * 512); }
    for (; unit < NUNIT; unit += G) {
        const int bh = unit >> 6, c = unit & 63, b = bh >> 2, h = bh & 3, T0 = c * 64;
        const u16* vtp = VAT + ((size_t)(b * 512 + h * 128 + w * 16 + l15)) * SEQ + T0 + 8 * g;
        const s8v vt0 = *(const s8v*)vtp, vt1 = *(const s8v*)(vtp + 32);
        float k0[8], k1[8], cum0[8], cum1[8]; float c0 = 0.f, c1 = 0.f;
#pragma unroll
        for (int i = 0; i < 8; ++i) { k0[i] = h2f((u16)(rk[i] & 0xffffu)); k1[i] = h2f((u16)(rk[i] >> 16)); }
#pragma unroll
        for (int i = 0; i < 8; ++i) { c0 += lg2(1.f - k0[i]); c1 += lg2(1.f - k1[i]); cum0[i] = c0; cum1[i] = c1; }
        *(LAS f32x2*)(BSEG + w * 128 + 2 * kp) = (f32x2){c0, c1};
        { const int nu = unit + G; if (nu < NUNIT) { const int nbh = nu >> 6, nc = nu & 63; const u16* kp_ = KA + ((size_t)(nbh >> 2) * SEQ + nc * 64 + 8 * w) * 512 + (nbh & 3) * 128 + 2 * kp;
#pragma unroll
            for (int i = 0; i < 8; ++i) rk[i] = *(const unsigned*)(kp_ + i * 512); } }
        __syncthreads();
        {
            float pre0 = 0.f, pre1 = 0.f, bm0 = 0.f, bm1 = 0.f, bl0 = 0.f, bl1 = 0.f;
#pragma unroll
            for (int s = 0; s < 8; ++s) { const f32x2 v = *(const LAS f32x2*)(BSEG + s * 128 + 2 * kp);
                if (s < w) { pre0 += v[0]; pre1 += v[1]; } if (s < 4) { bm0 += v[0]; bm1 += v[1]; } bl0 += v[0]; bl1 += v[1]; }
            if (w == 0) { *(f32x2*)(EBL + (size_t)unit * 128 + 2 * kp) = (f32x2){ex2(bl0), ex2(bl1)}; *(LAS f32x2*)(FAC + 256 + 2 * kp) = (f32x2){ex2(bl0 - bm0), ex2(bl1 - bm1)}; }
            float a0[8], a1[8];
#pragma unroll
            for (int i = 0; i < 8; ++i) { a0[i] = k0[i] * ex2(fminf(bm0 - (pre0 + cum0[i]), 126.f)); a1[i] = k1[i] * ex2(fminf(bm1 - (pre1 + cum1[i]), 126.f)); }
            u32x4 p0, p1;
            p0.x = pkbf(a0[0], a0[1]); p0.y = pkbf(a0[2], a0[3]); p0.z = pkbf(a0[4], a0[5]); p0.w = pkbf(a0[6], a0[7]);
            p1.x = pkbf(a1[0], a1[1]); p1.y = pkbf(a1[2], a1[3]); p1.z = pkbf(a1[4], a1[5]); p1.w = pkbf(a1[6], a1[7]);
            *(LAS u32x4*)(lds + SC_KTT + (2 * kp) * SC_TP + 16 * w) = p0;
            *(LAS u32x4*)(lds + SC_KTT + (2 * kp + 1) * SC_TP + 16 * w) = p1;
        }
        __syncthreads();
        unsigned long long* up = UBUF + (((size_t)unit * 8 + w) * 8) * 64 + lane;
#pragma unroll
        for (int kb = 0; kb < 8; ++kb) {
            f32x4 ua = (f32x4){0.f, 0.f, 0.f, 0.f};
            ua = MFMA16B(*(const LAS s8v*)(lds + SC_KTT + (16 * kb + l15) * SC_TP + (8 * g) * 2), vt0, ua);
            ua = MFMA16B(*(const LAS s8v*)(lds + SC_KTT + (16 * kb + l15) * SC_TP + (32 + 8 * g) * 2), vt1, ua);
            const f32x4 e2 = *(const LAS f32x4*)(FAC + 256 + 16 * kb + 4 * g);
            ua = ua * e2;
            up[kb * 64] = (unsigned long long)pkbf(ua[0], ua[1]) | ((unsigned long long)pkbf(ua[2], ua[3]) << 32);
        }
    }
}

struct HalfSync { volatile LAS unsigned* cnt; unsigned target; };
template <bool DRAIN_VM = true> __device__ __forceinline__ void half_sync(HalfSync& hs) {
    if (DRAIN_VM) asm volatile("s_waitcnt vmcnt(0) lgkmcnt(0)" ::: "memory");
    else asm volatile("s_waitcnt lgkmcnt(0)" ::: "memory");
    hs.target += 4u;
    if ((threadIdx.x & 63) == 0) __hip_atomic_fetch_add((LAS unsigned*)hs.cnt, 1u, __ATOMIC_RELAXED, __HIP_MEMORY_SCOPE_WORKGROUP);
    unsigned spins = 0;
    while ((int)(*hs.cnt - hs.target) < 0) { __builtin_amdgcn_s_sleep(1); if (++spins > (1u << 24)) break; }
    asm volatile("" ::: "memory");
}
constexpr int SA4_KTT = 0, SA4_FAC = 18432, SA4_BSEG = 18944, SA4_ZS = 20992;
__device__ __forceinline__ void scanA4_all(int bx, int G, LAS unsigned char* zl0, HalfSync& hs, const u16* KA, const u16* VAT, unsigned long long* UBUF, float* EBL) {
    int tid_ = threadIdx.x; asm volatile("" : "+v"(tid_));
    const int lane = tid_ & 63, w4 = __builtin_amdgcn_readfirstlane((tid_ >> 6) - 4), l15 = lane & 15, g = lane >> 4, kp = lane;
    unsigned rk[2][16];
#define SA4_RAW(U, Z) do { const int bh_ = (U) >> 6, c_ = (U) & 63; const u16* kp_ = KA + ((size_t)(bh_ >> 2) * SEQ + c_ * 64 + 16 * w4) * 512 + (bh_ & 3) * 128 + 2 * kp; \
        _Pragma("unroll") for (int i = 0; i < 16; ++i) rk[Z][i] = *(const unsigned*)(kp_ + i * 512); } while (0)
    int ub = bx;
    if (ub < NUNIT) { SA4_RAW(ub, 0); const int u1 = (ub + G < NUNIT) ? ub + G : ub; SA4_RAW(u1, 1); }
    for (; ub < NUNIT; ub += 2 * G) {
        int un[2]; un[0] = ub; un[1] = (ub + G < NUNIT) ? ub + G : ub;
        s8v vt[2][2][2]; float cum0[2][16], cum1[2][16];
#pragma unroll
        for (int z = 0; z < 2; ++z) {
            const int unit = un[z], bh = unit >> 6, c = unit & 63, b = bh >> 2, h = bh & 3, T0 = c * 64;
            LAS float* BSEG = (LAS float*)(zl0 + z * SA4_ZS + SA4_BSEG);
#pragma unroll
            for (int y = 0; y < 2; ++y) { const u16* vtp = VAT + ((size_t)(b * 512 + h * 128 + (2 * w4 + y) * 16 + l15)) * SEQ + T0 + 8 * g; vt[z][y][0] = *(const s8v*)vtp; vt[z][y][1] = *(const s8v*)(vtp + 32); }
            float c0 = 0.f, c1 = 0.f;
#pragma unroll
            for (int i = 0; i < 16; ++i) { c0 += lg2(1.f - h2f((u16)(rk[z][i] & 0xffffu))); c1 += lg2(1.f - h2f((u16)(rk[z][i] >> 16))); cum0[z][i] = c0; cum1[z][i] = c1; }
            *(LAS f32x2*)(BSEG + w4 * 128 + 2 * kp) = (f32x2){c0, c1};
        }
        half_sync<false>(hs);
#pragma unroll
        for (int z = 0; z < 2; ++z) {
            const int unit = un[z];
            LAS unsigned char* zl = zl0 + z * SA4_ZS; LAS float* FAC = (LAS float*)(zl + SA4_FAC); LAS float* BSEG = (LAS float*)(zl + SA4_BSEG);
            float pre0 = 0.f, pre1 = 0.f, bm0 = 0.f, bm1 = 0.f, bl0 = 0.f, bl1 = 0.f;
#pragma unroll
            for (int s = 0; s < 4; ++s) { const f32x2 v = *(const LAS f32x2*)(BSEG + s * 128 + 2 * kp);
                if (s < w4) { pre0 += v[0]; pre1 += v[1]; } if (s < 2) { bm0 += v[0]; bm1 += v[1]; } bl0 += v[0]; bl1 += v[1]; }
            if (w4 == 0) { *(f32x2*)(EBL + (size_t)unit * 128 + 2 * kp) = (f32x2){ex2(bl0), ex2(bl1)}; *(LAS f32x2*)(FAC + 2 * kp) = (f32x2){ex2(bl0 - bm0), ex2(bl1 - bm1)}; }
#pragma unroll
            for (int hh = 0; hh < 2; ++hh) {
                float a0[8], a1[8];
#pragma unroll
                for (int i = 0; i < 8; ++i) { const unsigned r_ = rk[z][8 * hh + i];
                    a0[i] = h2f((u16)(r_ & 0xffffu)) * ex2(fminf(bm0 - (pre0 + cum0[z][8 * hh + i]), 126.f)); a1[i] = h2f((u16)(r_ >> 16)) * ex2(fminf(bm1 - (pre1 + cum1[z][8 * hh + i]), 126.f)); }
                u32x4 p0, p1;
                p0.x = pkbf(a0[0], a0[1]); p0.y = pkbf(a0[2], a0[3]); p0.z = pkbf(a0[4], a0[5]); p0.w = pkbf(a0[6], a0[7]);
                p1.x = pkbf(a1[0], a1[1]); p1.y = pkbf(a1[2], a1[3]); p1.z = pkbf(a1[4], a1[5]); p1.w = pkbf(a1[6], a1[7]);
                *(LAS u32x4*)(zl + SA4_KTT + (2 * kp) * SC_TP + 32 * w4 + 16 * hh) = p0;
                *(LAS u32x4*)(zl + SA4_KTT + (2 * kp + 1) * SC_TP + 32 * w4 + 16 * hh) = p1;
            }
        }
        { const int nb = ub + 2 * G; if (nb < NUNIT) { SA4_RAW(nb, 0); const int n1 = (nb + G < NUNIT) ? nb + G : nb; SA4_RAW(n1, 1); } }
        half_sync<false>(hs);
#pragma unroll
        for (int z = 0; z < 2; ++z) {
            const int unit = un[z];
            LAS unsigned char* zl = zl0 + z * SA4_ZS; LAS float* FAC = (LAS float*)(zl + SA4_FAC);
#pragma unroll
            for (int y = 0; y < 2; ++y) {
                unsigned long long* up = UBUF + (((size_t)unit * 8 + (2 * w4 + y)) * 8) * 64 + lane;
#pragma unroll
                for (int kb = 0; kb < 8; ++kb) {
                    f32x4 ua = (f32x4){0.f, 0.f, 0.f, 0.f};
                    ua = MFMA16B(*(const LAS s8v*)(zl + SA4_KTT + (16 * kb + l15) * SC_TP + (8 * g) * 2), vt[z][y][0], ua);
                    ua = MFMA16B(*(const LAS s8v*)(zl + SA4_KTT + (16 * kb + l15) * SC_TP + (32 + 8 * g) * 2), vt[z][y][1], ua);
                    const f32x4 e2 = *(const LAS f32x4*)(FAC + 16 * kb + 4 * g);
                    ua = ua * e2;
                    up[kb * 64] = (unsigned long long)pkbf(ua[0], ua[1]) | ((unsigned long long)pkbf(ua[2], ua[3]) << 32);
                }
            }
        }
    }
#undef SA4_RAW
}

__device__ __forceinline__ void scanB_all(int bx, int G, unsigned long long* UBUF, const float* EBL) {
    int tid_ = threadIdx.x; asm volatile("" : "+v"(tid_));
    constexpr int NSLOT = BATCH * 4 * 8 * 8 * 64;
    for (int s0 = bx * 256 + (tid_ & 255); s0 < NSLOT; s0 += 2 * G * 256) {
        const bool two = (s0 + G * 256 < NSLOT);
        const int sl[2] = {s0, two ? s0 + G * 256 : s0};
        unsigned long long* up[2]; const float* ep[2]; f32x4 S[2];
#pragma unroll
        for (int z = 0; z < 2; ++z) {
            const int slot = sl[z], ln = slot & 63, kb = (slot >> 6) & 7, w = (slot >> 9) & 7, bh = slot >> 12, g = ln >> 4;
            up[z] = UBUF + ((((size_t)bh * 64) * 8 + w) * 8 + kb) * 64 + ln;
            ep[z] = EBL + ((size_t)bh * 64) * 128 + 16 * kb + 4 * g;
            S[z] = (f32x4){0.f, 0.f, 0.f, 0.f};
        }
        for (int c0 = 0; c0 < 64; c0 += 8) {
            unsigned long long uv[2][8]; f32x4 ev[2][8];
#pragma unroll
            for (int z = 0; z < 2; ++z)
#pragma unroll
                for (int j = 0; j < 8; ++j) { uv[z][j] = up[z][(size_t)(c0 + j) * 4096]; ev[z][j] = *(const f32x4*)(ep[z] + (size_t)(c0 + j) * 128); }
#pragma unroll
            for (int z = 0; z < 2; ++z)
#pragma unroll
                for (int j = 0; j < 8; ++j) {
                    const unsigned lo = (unsigned)uv[z][j], hi = (unsigned)(uv[z][j] >> 32);
                    const f32x4 u4 = (f32x4){__uint_as_float(lo << 16), __uint_as_float(lo & 0xffff0000u), __uint_as_float(hi << 16), __uint_as_float(hi & 0xffff0000u)};
                    S[z] = ev[z][j] * S[z] + u4;
                    if (z == 0 || two) up[z][(size_t)(c0 + j) * 4096] = (unsigned long long)pkbf(S[z][0], S[z][1]) | ((unsigned long long)pkbf(S[z][2], S[z][3]) << 32);
                }
        }
    }
}

__device__ __forceinline__ void scanC_all(int bx, int G, LAS unsigned char* lds, const u16* QA, const u16* KA, const u16* VAT, const u16* GA, const unsigned long long* UBUF, u16* Y) {
    int tid_ = threadIdx.x; asm volatile("" : "+v"(tid_));
    const int tid = tid_, lane = tid & 63, w = __builtin_amdgcn_readfirstlane(tid >> 6), l15 = lane & 15, g = lane >> 4, kp = lane;
    LAS float* FAC = (LAS float*)(lds + SC_FAC); LAS float* BSEG = (LAS float*)(lds + SC_BSEG2); LAS float* SSQP = (LAS float*)(lds + SC_SSQ2);
    unsigned rk[8], rq[8];
    int unit = bx;
    if (unit < NUNIT) { const int bh = unit >> 6, c = unit & 63; const size_t o_ = ((size_t)(bh >> 2) * SEQ + c * 64 + 8 * w) * 512 + (bh & 3) * 128 + 2 * kp;
#pragma unroll
        for (int i = 0; i < 8; ++i) { rk[i] = *(const unsigned*)(KA + o_ + i * 512); rq[i] = *(const unsigned*)(QA + o_ + i * 512); } }
    for (; unit < NUNIT; unit += G) {
        const int bh = unit >> 6, c = unit & 63, b = bh >> 2, h = bh & 3, T0 = c * 64;
        const size_t rb = (size_t)b * SEQ;
        const u16* vtp = VAT + ((size_t)(b * 512 + h * 128 + w * 16 + l15)) * SEQ + T0 + 8 * g;
        const s8v vt0 = *(const s8v*)vtp, vt1 = *(const s8v*)(vtp + 32);
        unsigned long long sraw[8];
        { const unsigned long long* sp = UBUF + (((size_t)(c > 0 ? unit - 1 : unit) * 8 + w) * 8) * 64 + lane;
#pragma unroll
          for (int kb = 0; kb < 8; ++kb) { const unsigned long long v = sp[kb * 64]; sraw[kb] = (c > 0) ? v : 0ull; } }
        u32x2 gt[4];
#pragma unroll
        for (int ti = 0; ti < 4; ++ti) gt[ti] = *(const u32x2*)(GA + (rb + T0 + 16 * ti + l15) * 512 + h * 128 + 16 * w + 4 * g);
        float k0[8], k1[8], q0[8], q1[8], cum0[8], cum1[8]; float c0 = 0.f, c1 = 0.f;
#pragma unroll
        for (int i = 0; i < 8; ++i) { k0[i] = h2f((u16)(rk[i] & 0xffffu)); k1[i] = h2f((u16)(rk[i] >> 16)); q0[i] = __uint_as_float(rq[i] << 16); q1[i] = __uint_as_float(rq[i] & 0xffff0000u); }
#pragma unroll
        for (int i = 0; i < 8; ++i) { c0 += lg2(1.f - k0[i]); c1 += lg2(1.f - k1[i]); cum0[i] = c0; cum1[i] = c1; }
        *(LAS f32x2*)(BSEG + w * 128 + 2 * kp) = (f32x2){c0, c1};
        { const int nu = unit + G; if (nu < NUNIT) { const int nbh = nu >> 6, nc = nu & 63; const size_t o_ = ((size_t)(nbh >> 2) * SEQ + nc * 64 + 8 * w) * 512 + (nbh & 3) * 128 + 2 * kp;
#pragma unroll
            for (int i = 0; i < 8; ++i) { rk[i] = *(const unsigned*)(KA + o_ + i * 512); rq[i] = *(const unsigned*)(QA + o_ + i * 512); } } }
        __syncthreads();
        {
            float pre0 = 0.f, pre1 = 0.f, bm0 = 0.f, bm1 = 0.f;
#pragma unroll
            for (int s = 0; s < 7; ++s) { const f32x2 v = *(const LAS f32x2*)(BSEG + s * 128 + 2 * kp);
                if (s < w) { pre0 += v[0]; pre1 += v[1]; } if (s < 4) { bm0 += v[0]; bm1 += v[1]; } }
            if (w == 0) *(LAS f32x2*)(FAC + 2 * kp) = (f32x2){ex2(bm0), ex2(bm1)};
#pragma unroll
            for (int i = 0; i < 8; ++i) {
                const float d0 = pre0 + cum0[i] - bm0, d1 = pre1 + cum1[i] - bm1; const int t = 8 * w + i;
                *(LAS unsigned*)(lds + SC_QT + t * SC_QP + kp * 4) = pkbf(q0[i] * ex2(fminf(d0, 126.f)), q1[i] * ex2(fminf(d1, 126.f)));
                *(LAS unsigned*)(lds + SC_KT + t * SC_QP + kp * 4) = pkbf(k0[i] * ex2(fminf(-d0, 126.f)), k1[i] * ex2(fminf(-d1, 126.f)));
            }
        }
        __syncthreads();
        for (int id = w; id < 16; id += 8) {
            const int ti = id >> 2, sj = id & 3;
            f32x4 p = (f32x4){0.f, 0.f, 0.f, 0.f};
            if (sj <= ti) {
#pragma unroll
                for (int c4 = 0; c4 < 4; ++c4) {
                    const s8v a = *(const LAS s8v*)(lds + SC_KT + (16 * sj + l15) * SC_QP + (32 * c4 + 8 * g) * 2);
                    const s8v bb = *(const LAS s8v*)(lds + SC_QT + (16 * ti + l15) * SC_QP + (32 * c4 + 8 * g) * 2);
                    p = MFMA16B(a, bb, p);
                }
            }
            const int t = 16 * ti + l15, s0 = 16 * sj + 4 * g;
            u32x2 pw; pw.x = pkbf(s0 <= t ? p[0] : 0.f, s0 + 1 <= t ? p[1] : 0.f); pw.y = pkbf(s0 + 2 <= t ? p[2] : 0.f, s0 + 3 <= t ? p[3] : 0.f);
            *(LAS u32x2*)(lds + SC_PP + t * SC_TP + s0 * 2) = pw;
        }
        s8v sbf[4];
#pragma unroll
        for (int c4 = 0; c4 < 4; ++c4) {
            const f32x4 e0 = *(const LAS f32x4*)(FAC + 32 * c4 + 4 * g), e1 = *(const LAS f32x4*)(FAC + 32 * c4 + 16 + 4 * g);
            const unsigned a0 = (unsigned)sraw[2 * c4], a1 = (unsigned)(sraw[2 * c4] >> 32), b0 = (unsigned)sraw[2 * c4 + 1], b1 = (unsigned)(sraw[2 * c4 + 1] >> 32);
            u32x4 pk;
            pk.x = pkbf(__uint_as_float(a0 << 16) * e0[0], __uint_as_float(a0 & 0xffff0000u) * e0[1]); pk.y = pkbf(__uint_as_float(a1 << 16) * e0[2], __uint_as_float(a1 & 0xffff0000u) * e0[3]);
            pk.z = pkbf(__uint_as_float(b0 << 16) * e1[0], __uint_as_float(b0 & 0xffff0000u) * e1[1]); pk.w = pkbf(__uint_as_float(b1 << 16) * e1[2], __uint_as_float(b1 & 0xffff0000u) * e1[3]);
            sbf[c4] = __builtin_bit_cast(s8v, pk);
        }
        __syncthreads();
        f32x4 o[4];
#pragma unroll
        for (int ti = 0; ti < 4; ++ti) {
            f32x4 oo = (f32x4){0.f, 0.f, 0.f, 0.f};
            oo = MFMA16B(vt0, *(const LAS s8v*)(lds + SC_PP + (16 * ti + l15) * SC_TP + (8 * g) * 2), oo);
            oo = MFMA16B(vt1, *(const LAS s8v*)(lds + SC_PP + (16 * ti + l15) * SC_TP + (32 + 8 * g) * 2), oo);
#pragma unroll
            for (int c4 = 0; c4 < 4; ++c4) {
                const s4v lo = *(const LAS s4v*)(lds + SC_QT + (16 * ti + l15) * SC_QP + (32 * c4 + 4 * g) * 2);
                const s4v hh = *(const LAS s4v*)(lds + SC_QT + (16 * ti + l15) * SC_QP + (32 * c4 + 16 + 4 * g) * 2);
                oo = MFMA16B(sbf[c4], __builtin_shufflevector(lo, hh, 0, 1, 2, 3, 4, 5, 6, 7), oo);
            }
            o[ti] = oo;
        }
#pragma unroll
        for (int ti = 0; ti < 4; ++ti) {
            float s = (o[ti][0] * o[ti][0] + o[ti][1] * o[ti][1]) + (o[ti][2] * o[ti][2] + o[ti][3] * o[ti][3]);
            s += __shfl_xor(s, 16); s += __shfl_xor(s, 32);
            if (g == 0) SSQP[(16 * ti + l15) * 8 + w] = s;
        }
        __syncthreads();
#pragma unroll
        for (int ti = 0; ti < 4; ++ti) {
            const int t = 16 * ti + l15;
            const f32x4 s0 = *(const LAS f32x4*)(SSQP + t * 8), s1 = *(const LAS f32x4*)(SSQP + t * 8 + 4);
            const float rs = rstd_of((s0[0] + s0[1]) + (s0[2] + s0[3]) + (s1[0] + s1[1]) + (s1[2] + s1[3]), 128.f);
            const float g0 = __uint_as_float(gt[ti].x << 16), g1 = __uint_as_float(gt[ti].x & 0xffff0000u), g2 = __uint_as_float(gt[ti].y << 16), g3 = __uint_as_float(gt[ti].y & 0xffff0000u);
            u32x2 yo; yo.x = pkbf(o[ti][0] * rs * g0, o[ti][1] * rs * g1); yo.y = pkbf(o[ti][2] * rs * g2, o[ti][3] * rs * g3);
            *(u32x2*)(Y + (rb + T0 + t) * 1024 + h * 128 + 16 * w + 4 * g) = yo;
        }
    }
}

#define XB_TMO      128
#define XB_XCNT(j)  (256  + 64 * (j))
#define XB_XSUB(j)  (1280 + 64 * (j))
#define XB_XGEN(j)  (2304 + 64 * (j))
#define XB_TOP      3328
#define XB_TOPGEN   3392
#define XCD_BAR_WORDS 3456
#define XB_SPIN_CAP (1u << 18)

__device__ __forceinline__ unsigned xb_ld(unsigned* p)              { return __hip_atomic_load(p, __ATOMIC_RELAXED, __HIP_MEMORY_SCOPE_AGENT); }
__device__ __forceinline__ unsigned xb_add(unsigned* p, unsigned v) { return __hip_atomic_fetch_add(p, v, __ATOMIC_RELAXED, __HIP_MEMORY_SCOPE_AGENT); }
__device__ __forceinline__ unsigned xb_xcc_id() { return (unsigned)__builtin_amdgcn_s_getreg((3 << 11) | 20) & 0xFu; }
#define XB_SPIN(cond, bar) do { unsigned _sp = 0; while (cond) { __builtin_amdgcn_s_sleep(1); \
    if ((++_sp & 255u) == 0u) { if (xb_ld(&(bar)[XB_TMO])) break; if (_sp > XB_SPIN_CAP) { atomicAdd(&(bar)[XB_TMO], 1u); break; } } } } while (0)

struct XcdBarrier {
    unsigned* bar; unsigned x;
    volatile LAS unsigned* st;
};

__device__ __forceinline__ XcdBarrier xcd_barrier_post(unsigned* bar, volatile LAS unsigned* st) {
    XcdBarrier b; b.bar = bar; b.x = xb_xcc_id(); b.st = st;
    if (threadIdx.x == 0) (void)xb_add(&bar[XB_XCNT(b.x)], 1u);
    return b;
}
__device__ __forceinline__ void xcd_barrier_complete(unsigned* bar, unsigned x, unsigned& nloc, unsigned& nx) {
    const unsigned G = gridDim.x * gridDim.y * gridDim.z;
    unsigned sum, cnt, mine, sp = 0u;
    for (;;) {
        sum = 0u; cnt = 0u; mine = 0u;
#pragma unroll
        for (unsigned j = 0; j < 16; ++j) { const unsigned c = xb_ld(&bar[XB_XCNT(j)]); sum += c; cnt += (c > 0u) ? 1u : 0u; mine = (j == x) ? c : mine; }
        if (sum == G) break;
        __builtin_amdgcn_s_sleep(1);
        if ((++sp & 255u) == 0u) { if (xb_ld(&bar[XB_TMO])) break; if (sp > XB_SPIN_CAP) { atomicAdd(&bar[XB_TMO], 1u); break; } }
    }
    nloc = mine > 0u ? mine : 1u; nx = cnt > 0u ? cnt : 1u;
}

__device__ __forceinline__ void xcd_barrier(const XcdBarrier& b) {
    asm volatile("s_waitcnt vmcnt(0)" ::: "memory");
    __syncthreads();
    if (threadIdx.x == 0) {
        unsigned* bar = b.bar;
        __builtin_amdgcn_s_waitcnt(0);
        unsigned nloc = b.st[0], nx = b.st[1];
        if (nloc == 0u) { xcd_barrier_complete(bar, b.x, nloc, nx); b.st[0] = nloc; b.st[1] = nx; }
        const unsigned old = xb_add(&bar[XB_XSUB(b.x)], 1u);
        const unsigned gen = old / nloc;
        if (old + 1u == (gen + 1u) * nloc) {
            __builtin_amdgcn_fence(__ATOMIC_RELEASE, "agent");
            asm volatile("s_waitcnt vmcnt(0)" ::: "memory");
            const unsigned og = xb_add(&bar[XB_TOP], 1u);
            const unsigned tg = og / nx;
            if (og + 1u == (tg + 1u) * nx) xb_add(&bar[XB_TOPGEN], 1u);
            else XB_SPIN(xb_ld(&bar[XB_TOPGEN]) == tg, bar);
            __builtin_amdgcn_fence(__ATOMIC_ACQUIRE, "agent");
            xb_add(&bar[XB_XGEN(b.x)], 1u);
            asm volatile("s_waitcnt vmcnt(0)" ::: "memory");
        } else {
            XB_SPIN(xb_ld(&bar[XB_XGEN(b.x)]) == gen, bar);
            __builtin_amdgcn_fence(__ATOMIC_ACQUIRE, "agent");
            asm volatile("s_waitcnt vmcnt(0)" ::: "memory");
        }
    }
    __syncthreads();
}
__device__ __forceinline__ void xcd_barrier_upper(const XcdBarrier& b, HalfSync& hs) {
    half_sync(hs);
    if (threadIdx.x == 256) {
        unsigned* bar = b.bar;
        __builtin_amdgcn_s_waitcnt(0);
        unsigned nloc = b.st[0], nx = b.st[1];
        if (nloc == 0u) { xcd_barrier_complete(bar, b.x, nloc, nx); b.st[0] = nloc; b.st[1] = nx; }
        const unsigned old = xb_add(&bar[XB_XSUB(b.x)], 1u);
        const unsigned gen = old / nloc;
        if (old + 1u == (gen + 1u) * nloc) {
            __builtin_amdgcn_fence(__ATOMIC_RELEASE, "agent");
            asm volatile("s_waitcnt vmcnt(0)" ::: "memory");
            const unsigned og = xb_add(&bar[XB_TOP], 1u);
            const unsigned tg = og / nx;
            if (og + 1u == (tg + 1u) * nx) xb_add(&bar[XB_TOPGEN], 1u);
            else XB_SPIN(xb_ld(&bar[XB_TOPGEN]) == tg, bar);
            __builtin_amdgcn_fence(__ATOMIC_ACQUIRE, "agent");
            xb_add(&bar[XB_XGEN(b.x)], 1u);
            asm volatile("s_waitcnt vmcnt(0)" ::: "memory");
        } else {
            XB_SPIN(xb_ld(&bar[XB_XGEN(b.x)]) == gen, bar);
            __builtin_amdgcn_fence(__ATOMIC_ACQUIRE, "agent");
            asm volatile("s_waitcnt vmcnt(0)" ::: "memory");
        }
    }
    half_sync(hs);
}

#ifndef MK_MULTI
#define MK_MULTI 0
#endif
struct Args { const float* in[13]; float* out; unsigned char* ws; int ph_lo, ph_hi; };

__global__ void __launch_bounds__(512, 2) fwd_kernel(Args a) {
    extern __shared__ __attribute__((aligned(16))) unsigned char lds_raw[];
    LAS unsigned char* lds = (LAS unsigned char*)lds_raw;
    cg::grid_group grid = cg::this_grid();
    const int wave = __builtin_amdgcn_readfirstlane((int)threadIdx.x >> 6);
    const int G = gridDim.x, bx = blockIdx.x;
    const int gw = bx * 8 + wave, NGW = G * 8;
    unsigned char* ws = a.ws;
    unsigned* ctl = (unsigned*)(ws + WS_CTL);
    float* ssq = (float*)(ws + WS_CTL + CTL_SSQ);
    u16* WIN = (u16*)(ws + WS_WIN); u16* WOUT = (u16*)(ws + WS_WOUT); u16* WG = (u16*)(ws + WS_WG); u16* WP = (u16*)(ws + WS_WP);
    float* lbv = (float*)(ws + WS_SMALL);
    u16* PB = (u16*)(ws + WS_PB); u16* X0 = (u16*)(ws + WS_X0); u16* X1 = (u16*)(ws + WS_X1); u16* PROJ = (u16*)(ws + WS_PROJ); u16* PE = (u16*)(ws + WS_PE);
    const int lo = a.ph_lo, hi = a.ph_hi;
    volatile LAS unsigned* bst = (volatile LAS unsigned*)(lds + 147456 + 64);
    if (threadIdx.x < 8) bst[threadIdx.x] = 0u;
    __syncthreads();
    XcdBarrier xbar = xcd_barrier_post(ctl + 4096, bst);
    if (threadIdx.x == 256) (void)xb_add(&(ctl + 8192)[XB_XCNT(xbar.x)], 1u);
#define IN(k) (lo <= (k) && (k) < hi)
#define SEAM(k) do { if (IN(k) && IN((k) + 1)) { if (hi > 1000) grid.sync(); else xcd_barrier(xbar); } } while (0)

    if (IN(0)) {
        int tid_ = threadIdx.x; asm volatile("" : "+v"(tid_)); const int tid = tid_, lane = tid & 63;
        {
        LAS float* scr = (LAS float*)(lds + wave * 16384);
        constexpr int I_IN0 = (DM / 64) * (DIN / 32);
        for (int it = gw; it < I_IN0; it += NGW) p0_transpose_item(a.in[3], DM, DIN, WIN, a.in[2], nullptr, DM, scr, it, lane);
        for (int m0 = gw * 2; m0 < MTOK; m0 += NGW * 2) {
            f32x4 v[2][4];
#pragma unroll
            for (int r = 0; r < 2; ++r)
#pragma unroll
                for (int j = 0; j < 4; ++j) v[r][j] = *((const f32x4*)(a.in[0] + (size_t)(m0 + r) * DM) + lane + 64 * j);
#pragma unroll
            for (int r = 0; r < 2; ++r) {
                unsigned long long* o8 = (unsigned long long*)(X0 + (size_t)(m0 + r) * DM) + lane; float s = 0.f;
#pragma unroll
                for (int j = 0; j < 4; ++j) { const f32x4 x = v[r][j]; s += (x[0] * x[0] + x[1] * x[1]) + (x[2] * x[2] + x[3] * x[3]);
                    o8[64 * j] = (unsigned long long)pkbf(x[0], x[1]) | ((unsigned long long)pkbf(x[2], x[3]) << 32); }
                s = wave_sum(s);
                if (lane == 0) ssq[m0 + r] = s;
            }
        }
        if (bx == 0) { const float l0 = a.in[7][tid], l1 = a.in[7][512 + tid]; lbv[tid] = 1.f; lbv[512 + tid] = 1.f - 1.f / (1.f + __expf(l0 - l1)); }
        __syncthreads();
        }
    }
    SEAM(0);

    for (int l = 0; l < DEPTH; ++l) {
        const int pb = 1 + 5 * l;
        u16* XA = (l & 1) ? X1 : X0;
        u16* XB = (l & 1) ? X0 : X1;
        float* ssq_in = ssq + (size_t)(l == 0 ? 0 : 3 + 3 * (l - 1)) * MTOK;
        float* ssq_pe = ssq + (size_t)(1 + 3 * l) * MTOK; float* ssq_h1 = ssq + (size_t)(2 + 3 * l) * MTOK; float* ssq_h2 = ssq + (size_t)(3 + 3 * l) * MTOK;
        if (IN(pb)) {
            { pg8::Gemm g{XA, WIN + (size_t)l * DIN * DM, MTOK, DIN, DM}; pg8::StaticOrder S; S.init(MTOK, DIN, G, bx);
              EpiProj E{ssq_in, lbv + l * 512, PROJ};
              pg8::gemm_phase<EpiProj, pg8::StaticOrder, true, true>(lds, g, S, E);
            }
        }
        SEAM(pb);
        unsigned long long* UBUF = (unsigned long long*)a.out;
        float* EBL = (float*)(ws + WS_EBL);
        if (IN(pb + 1)) {
            if (wave < 4) {
                const int vcu = (G % 8 == 0) ? (bx % 8) * (G / 8) + bx / 8 : bx;
                    for (int u = vcu * 4 + wave; u < BATCH * 8 * (SEQ / 32); u += G * 4) {
                        attn_unit(u, lds + wave * 18432, PROJ + 4 * SEGSZ, PROJ + 5 * SEGSZ, PROJ + 6 * SEGSZ, PROJ + 7 * SEGSZ, XB);
                    }
            } else {
                volatile LAS unsigned* bst2 = (volatile LAS unsigned*)(lds + 147456 + 64);
                XcdBarrier ubar; ubar.bar = ctl + 8192; ubar.x = xb_xcc_id(); ubar.st = bst2 + 2;
                const int nu4 = (bx < NUNIT) ? ((NUNIT - bx + G - 1) / G + 1) / 2 : 0;
                HalfSync hs; hs.cnt = bst2 + 4; hs.target = (unsigned)(l * 4 * (2 * nu4 + 3));
                scanA4_all(bx, G, lds + 73728, hs, PROJ + 1 * SEGSZ, PROJ + 2 * SEGSZ, UBUF, EBL);
                xcd_barrier_upper(ubar, hs);
                scanB_all(bx, G, UBUF, EBL);
                half_sync<false>(hs);
                {
                    int tq_ = threadIdx.x; asm volatile("" : "+v"(tq_)); const int t4 = tq_ & 255, ln = tq_ & 63;
                    LAS float* scr = (LAS float*)(lds + 73728 + (wave - 4) * 16384);
                    const int gw4 = bx * 4 + (wave - 4), NGW4 = G * 4;
                    constexpr int I_IN = (DM / 64) * (DIN / 32), I_SQ = (DM / 64) * (DM / 32), I_P = (DPLE / 64) * (DM / 32);
                    const int nit = 2 * I_SQ + I_P + ((l + 1 < DEPTH) ? I_IN : 0);
                    for (int it = gw4; it < nit; it += NGW4) {
                        int r = it;
                        if (r < I_SQ) { p0_transpose_item(a.in[6] + (size_t)l * DM * DM, DM, DM, WOUT + (size_t)l * DM * DM, a.in[4] + l * 512, a.in[5] + l * 512, 512, scr, r, ln); continue; } r -= I_SQ;
                        if (r < I_SQ) { p0_transpose_item(a.in[9] + (size_t)l * DM * DM, DM, DM, WG + (size_t)l * DM * DM, a.in[8] + l * DM, nullptr, DM, scr, r, ln); continue; } r -= I_SQ;
                        if (r < I_P) { p0_transpose_item(a.in[10] + (size_t)l * DPLE * DM, DPLE, DM, WP + (size_t)l * DM * DPLE, nullptr, nullptr, 0, scr, r, ln); continue; } r -= I_P;
                        p0_transpose_item(a.in[3] + (size_t)(l + 1) * DM * DIN, DM, DIN, WIN + (size_t)(l + 1) * DIN * DM, a.in[2] + (l + 1) * DM, nullptr, DM, scr, r, ln);
                    }
                    const size_t NP = (size_t)MTOK * DPLE / 8, ST = (size_t)G * 256;
                    const f32x4* src = (const f32x4*)(a.in[1] + (size_t)l * MTOK * DPLE); u32x4* dst = (u32x4*)(PB + (size_t)l * MTOK * DPLE);
                    size_t i = (size_t)bx * 256 + t4;
                    for (; i + 7 * ST < NP; i += 8 * ST) {
                        f32x4 v0[8], v1[8];
#pragma unroll
                        for (int j = 0; j < 8; ++j) { const size_t ii = i + j * ST; v0[j] = src[2 * ii]; v1[j] = src[2 * ii + 1]; }
#pragma unroll
                        for (int j = 0; j < 8; ++j) { const size_t ii = i + j * ST; u32x4 o; o.x = pkbf(v0[j][0], v0[j][1]); o.y = pkbf(v0[j][2], v0[j][3]); o.z = pkbf(v1[j][0], v1[j][1]); o.w = pkbf(v1[j][2], v1[j][3]); dst[ii] = o; }
                    }
                    for (; i < NP; i += ST) { const f32x4 v0 = src[2 * i], v1 = src[2 * i + 1]; u32x4 o; o.x = pkbf(v0[0], v0[1]); o.y = pkbf(v0[2], v0[3]); o.z = pkbf(v1[0], v1[1]); o.w = pkbf(v1[2], v1[3]); dst[i] = o; }
                }
            }
            __syncthreads();
        }
        SEAM(pb + 1);
        if (IN(pb + 2)) {
            scanC_all(bx, G, lds, PROJ + 0 * SEGSZ, PROJ + 1 * SEGSZ, PROJ + 2 * SEGSZ, PROJ + 3 * SEGSZ, UBUF, XB);
            __syncthreads();
            { int kple = DPLE; asm volatile("" : "+s"(kple));
              pg8::Gemm g{PB + (size_t)l * MTOK * DPLE, WP + (size_t)l * DM * DPLE, MTOK, DM, kple}; pg8::StaticOrder S; S.init(MTOK, DM, G, bx);
              EpiPe E{PE, ssq_pe};
              pg8::gemm_phase<EpiPe, pg8::StaticOrder, true, true>(lds, g, S, E);
            }
        }
        SEAM(pb + 2);
        if (IN(pb + 3)) {
            pg8::Gemm g{XB, WOUT + (size_t)l * DM * DM, MTOK, DM, DM}; pg8::StaticOrder S; S.init(MTOK, DM, G, bx);
            EpiH1 E{XA, ssq_h1};
            pg8::gemm_phase<EpiH1, pg8::StaticOrder, true, true>(lds, g, S, E);
        }
        SEAM(pb + 3);
        if (IN(pb + 4)) {
            pg8::Gemm g{XA, WG + (size_t)l * DM * DM, MTOK, DM, DM}; pg8::StaticOrder S; S.init(MTOK, DM, G, bx);
            EpiGate E{ssq_h1, ssq_pe, a.in[11] + l * DM, PE, XA, XB, ssq_h2};
            pg8::gemm_phase<EpiGate, pg8::StaticOrder, true, true>(lds, g, S, E);
        }
        SEAM(pb + 4);
    }
    if (IN(NPHASE - 1)) {
        int tidf_ = threadIdx.x; asm volatile("" : "+v"(tidf_)); const int lane = tidf_ & 63;
        const float* sq = ssq + (size_t)(3 + 3 * (DEPTH - 1)) * MTOK;
        const u16* HL = ((DEPTH - 1) & 1) ? X0 : X1;
        for (int m0 = gw * 2; m0 < MTOK; m0 += NGW * 2) {
            u32x4 hv[2][2]; float sv[2];
#pragma unroll
            for (int r = 0; r < 2; ++r) { sv[r] = sq[m0 + r];
#pragma unroll
                for (int j = 0; j < 2; ++j) hv[r][j] = *(const u32x4*)(HL + (size_t)(m0 + r) * DM + 512 * j + 8 * lane); }
#pragma unroll
            for (int r = 0; r < 2; ++r) { const float rs = rstd_of(sv[r], 1024.f);
#pragma unroll
                for (int j = 0; j < 2; ++j) { f32x4 a0, a1; unpack8(hv[r][j], a0, a1);
                    const f32x4 g0 = *(const f32x4*)(a.in[12] + 512 * j + 8 * lane), g1 = *(const f32x4*)(a.in[12] + 512 * j + 8 * lane + 4);
                    float* op = a.out + (size_t)(m0 + r) * DM + 512 * j + 8 * lane;
                    *(f32x4*)op = a0 * rs * g0; *(f32x4*)(op + 4) = a1 * rs * g1; } }
        }
    }
#undef IN
#undef SEAM
}

extern "C" void kernel_launch(void* const* d_in, const int* in_sizes, int n_in, void* d_out, int out_size, void* d_ws, size_t ws_size, hipStream_t stream) {
    static int grid = 0;
    if (grid == 0) {
        if (n_in != 13 || in_sizes[0] != MTOK * DM || out_size != MTOK * DM || ws_size < WS_END) {
            fprintf(stderr, "kernel_launch: unexpected shapes (n_in %d, in0 %d, out %d, ws %zu); nothing launched\n", n_in, n_in > 0 ? in_sizes[0] : -1, out_size, ws_size); grid = -1; return; }
        int dev = 0, cus = 0, per_cu = 0;
        hipGetDevice(&dev);
        hipDeviceGetAttribute(&cus, hipDeviceAttributeMultiprocessorCount, dev);
        if (hipFuncSetAttribute((const void*)fwd_kernel, hipFuncAttributeMaxDynamicSharedMemorySize, LDS_BYTES) != hipSuccess) { fprintf(stderr, "kernel_launch: hipFuncSetAttribute failed\n"); grid = -1; return; }
        if (hipOccupancyMaxActiveBlocksPerMultiprocessor(&per_cu, (const void*)fwd_kernel, 512, LDS_BYTES) != hipSuccess || per_cu < 1) { fprintf(stderr, "kernel_launch: occupancy query gave %d\n", per_cu); per_cu = 1; }
        (void)hipGetLastError();
        grid = cus * per_cu;
        if (grid < 32) { fprintf(stderr, "kernel_launch: grid %d too small\n", grid); grid = -1; return; }
    }
    if (grid < 0) return;
    (void)hipMemsetAsync((char*)d_ws + WS_CTL, 0, CTL_BYTES, stream);
    Args a{};
    for (int i = 0; i < 13; ++i) a.in[i] = (const float*)d_in[i];
    a.out = (float*)d_out; a.ws = (unsigned char*)d_ws;
#if MK_MULTI
    for (int ph = 0; ph < NPHASE; ++ph) { a.ph_lo = ph; a.ph_hi = ph + 1; hipLaunchKernelGGL(fwd_kernel, dim3(grid), dim3(512), LDS_BYTES, stream, a); }
#else
    a.ph_lo = 0; a.ph_hi = NPHASE;
    void* args[] = {&a};
    hipError_t e = hipLaunchCooperativeKernel((const void*)fwd_kernel, dim3(grid), dim3(512), args, LDS_BYTES, stream);
    if (e != hipSuccess) fprintf(stderr, "kernel_launch: cooperative launch failed: %s (grid %d)\n", hipGetErrorString(e), grid);
#endif
}
```
